# Optimizing an MI355X kernel written in HIP

```python
import math
import jax
import jax.numpy as jnp
from jax import lax
import numpy as np

D_MODEL = 4096
BATCH = 2
SEQ = 4096
DEPTH = 4

CTX_LEN = 256
GRID_W = 64
N_MIXERS = 3
D_FF = 4 * D_MODEL
ADA_RANK = 512
N_MOD = 6
ROPE_BASE = 10000.0
LN_EPS = 1e-5
RMS_EPS = 1e-6
Q_BLOCK = 128
DN_ALPHA = (2.0 * DEPTH) ** 0.25
DN_BETA = (8.0 * DEPTH) ** -0.25

DA_QK_DIM = 64
DA_V_DIM = 2 * DA_QK_DIM
DA_HEADS = D_MODEL // DA_V_DIM
MLA_HEADS = D_MODEL // 64
MLA_Q_RANK = 1536
MLA_KV_RANK = 512
MLA_NOPE = 128
MLA_ROPE = 64
MLA_V = 128
NA_HEAD_DIM = 128
NA_HEADS = D_MODEL // NA_HEAD_DIM
NA_WIN_ROWS = 8
NA_WIN_COLS = 16

N_DA = len(range(0, DEPTH, N_MIXERS))
N_MLA = len(range(1, DEPTH, N_MIXERS))
N_NA = len(range(2, DEPTH, N_MIXERS))

kernel_name = 'hybrid_diffattn_mla_natten_flow_backbone'


def layer_norm(x, g, b):
    xf = x.astype(jnp.float32)
    mu = jnp.mean(xf, -1, keepdims=True)
    var = jnp.mean(jnp.square(xf - mu), -1, keepdims=True)
    return ((xf - mu) * lax.rsqrt(var + LN_EPS)).astype(x.dtype) * g + b


def rms_norm(x, g, eps=RMS_EPS):
    xf = x.astype(jnp.float32)
    return (xf * lax.rsqrt(jnp.mean(jnp.square(xf), -1, keepdims=True) + eps)).astype(x.dtype) * g


def axial_rope(x, rows, cols):
    half = x.shape[-1] // 2
    quarter = half // 2
    inv = ROPE_BASE ** (-jnp.arange(quarter, dtype=jnp.float32) / quarter)

    def rot(xh, pos):
        ang = pos.astype(jnp.float32)[:, None] * inv
        cos = jnp.cos(ang)[:, None, :].astype(x.dtype)
        sin = jnp.sin(ang)[:, None, :].astype(x.dtype)
        x1, x2 = xh[..., :quarter], xh[..., quarter:]
        return jnp.concatenate([x1 * cos - x2 * sin, x1 * sin + x2 * cos], -1)

    return jnp.concatenate([rot(x[..., :half], rows), rot(x[..., half:], cols)], -1)


def modulation(cond, w1, w2, b):
    m = (jax.nn.silu(cond) @ w1) @ w2 + b
    return m.reshape(cond.shape[0], N_MOD, 1, D_MODEL)


def query_blocks(q):
    B, S = q.shape[:2]
    return jnp.moveaxis(q.reshape((B, S // Q_BLOCK, Q_BLOCK) + q.shape[2:]), 1, 0)


def merge_blocks(o):
    o = jnp.moveaxis(o, 0, 1)
    return o.reshape((o.shape[0], o.shape[1] * o.shape[2]) + o.shape[3:])


def sq_relu_mlp(h, w1, w2):
    return jnp.square(jax.nn.relu(h @ w1)) @ w2


def diff_attention(hl, hc, w_qkv, w_o, lq1, lk1, lq2, lk2, sub_g, lam_init, rows, cols, with_ctx):
    B, S, _ = hl.shape
    C = hc.shape[1]

    def project(h):
        q, k, v = jnp.split(h @ w_qkv, 3, axis=-1)
        L = h.shape[1]
        return (q.reshape(B, L, DA_HEADS * 2, DA_QK_DIM), k.reshape(B, L, DA_HEADS * 2, DA_QK_DIM),
                v.reshape(B, L, DA_HEADS, DA_V_DIM))

    ql, kl, vl = project(hl)
    qc, kc, vc = project(hc)
    comp = (DA_HEADS, 2, DA_QK_DIM)
    ql = axial_rope(ql, rows, cols).reshape((B, S) + comp)
    kl = axial_rope(kl, rows, cols).reshape((B, S) + comp)
    qc = qc.reshape((B, C) + comp)
    kc = kc.reshape((B, C) + comp)
    lam = (jnp.exp(jnp.sum(lq1 * lk1).astype(jnp.float32))
           - jnp.exp(jnp.sum(lq2 * lk2).astype(jnp.float32)) + lam_init)
    scale = DA_QK_DIM ** -0.5

    def attend(q, k, v):
        s = jnp.einsum('bqhcd,bkhcd->bhcqk', q, k).astype(jnp.float32) * scale
        p = jax.nn.softmax(s, axis=-1)
        a = (p[:, :, 0] - lam * p[:, :, 1]).astype(v.dtype)
        return jnp.einsum('bhqk,bkhd->bqhd', a, v)

    def finish(o):
        o = rms_norm(o, sub_g, eps=1e-5) * (1.0 - lam_init)
        return o.reshape(o.shape[0], o.shape[1], DA_HEADS * DA_V_DIM) @ w_o

    k_all = jnp.concatenate([kc, kl], axis=1)
    v_all = jnp.concatenate([vc, vl], axis=1)
    ol = merge_blocks(lax.map(lambda qb: attend(qb, k_all, v_all), query_blocks(ql)))
    yl = finish(ol)
    yc = finish(attend(qc, kc, vc)) if with_ctx else None
    return yl, yc


def mla_attention(hl, hc, w_down, q_g, w_uq, kv_g, w_ukv, w_o, rows, cols, with_ctx):
    def project(h, use_rope):
        B, L, _ = h.shape
        down = h @ w_down
        cq = rms_norm(down[..., :MLA_Q_RANK], q_g)
        ckv = rms_norm(down[..., MLA_Q_RANK:MLA_Q_RANK + MLA_KV_RANK], kv_g)
        k_rope = down[..., MLA_Q_RANK + MLA_KV_RANK:][:, :, None, :]
        q = (cq @ w_uq).reshape(B, L, MLA_HEADS, MLA_NOPE + MLA_ROPE)
        q_nope, q_rope = q[..., :MLA_NOPE], q[..., MLA_NOPE:]
        kv = (ckv @ w_ukv).reshape(B, L, MLA_HEADS, MLA_NOPE + MLA_V)
        k_nope, v = kv[..., :MLA_NOPE], kv[..., MLA_NOPE:]
        if use_rope:
            q_rope = axial_rope(q_rope, rows, cols)
            k_rope = axial_rope(k_rope, rows, cols)
        return q_nope, q_rope, k_nope, k_rope[:, :, 0], v

    scale = (MLA_NOPE + MLA_ROPE) ** -0.5

    def attend(q_nope, q_rope, k_nope, k_rope, v):
        s = (jnp.einsum('bqhd,bkhd->bhqk', q_nope, k_nope)
             + jnp.einsum('bqhr,bkr->bhqk', q_rope, k_rope)).astype(jnp.float32) * scale
        p = jax.nn.softmax(s, axis=-1).astype(v.dtype)
        return jnp.einsum('bhqk,bkhd->bqhd', p, v)

    def finish(o):
        return o.reshape(o.shape[0], o.shape[1], MLA_HEADS * MLA_V) @ w_o

    qn_l, qr_l, kn_l, kr_l, v_l = project(hl, True)
    qn_c, qr_c, kn_c, kr_c, v_c = project(hc, False)
    kn_all = jnp.concatenate([kn_c, kn_l], axis=1)
    kr_all = jnp.concatenate([kr_c, kr_l], axis=1)
    v_all = jnp.concatenate([v_c, v_l], axis=1)
    ol = merge_blocks(lax.map(lambda qs: attend(qs[0], qs[1], kn_all, kr_all, v_all),
                              (query_blocks(qn_l), query_blocks(qr_l))))
    yl = finish(ol)
    yc = finish(attend(qn_c, qr_c, kn_c, kr_c, v_c)) if with_ctx else None
    return yl, yc


def neighbourhood_attention(hl, hc, w_qkv, w_o, rpb, with_ctx):
    B, S, _ = hl.shape
    C = hc.shape[1]
    n_rows = S // GRID_W
    wr = min(NA_WIN_ROWS, n_rows)

    def project(h):
        q, k, v = jnp.split(h @ w_qkv, 3, axis=-1)
        shp = h.shape[:2] + (NA_HEADS, NA_HEAD_DIM)
        return q.reshape(shp), k.reshape(shp), v.reshape(shp)

    ql, kl, vl = project(hl)
    qc, kc, vc = project(hc)
    grid = (B, n_rows, GRID_W, NA_HEADS, NA_HEAD_DIM)
    qg, kg, vg = ql.reshape(grid), kl.reshape(grid), vl.reshape(grid)
    scale = NA_HEAD_DIM ** -0.5

    col = jnp.arange(GRID_W)
    col_start = jnp.clip(col - NA_WIN_COLS // 2, 0, GRID_W - NA_WIN_COLS)
    col_in = ((col[None, :] >= col_start[:, None])
              & (col[None, :] < col_start[:, None] + NA_WIN_COLS))
    col_idx = jnp.clip(col[None, :] - col[:, None] + NA_WIN_COLS - 1, 0, 2 * NA_WIN_COLS - 2)
    col_bias = rpb[:, :, col_idx].astype(jnp.float32)

    def row_block(r):
        r0 = jnp.clip(r - wr // 2, 0, n_rows - wr)
        q = lax.dynamic_index_in_dim(qg, r, axis=1, keepdims=False)
        kb = lax.dynamic_slice_in_dim(kg, r0, wr, axis=1)
        vb = lax.dynamic_slice_in_dim(vg, r0, wr, axis=1)
        row_idx = r0 + jnp.arange(wr) - r + NA_WIN_ROWS - 1
        bias = jnp.take(col_bias, row_idx, axis=1).transpose(0, 2, 1, 3)
        s_lat = jnp.einsum('bqhd,brkhd->bhqrk', q, kb).astype(jnp.float32) * scale + bias
        s_lat = jnp.where(col_in[:, None, :], s_lat, -jnp.inf)
        s_lat = s_lat.reshape(B, NA_HEADS, GRID_W, wr * GRID_W)
        s_ctx = jnp.einsum('bqhd,bkhd->bhqk', q, kc).astype(jnp.float32) * scale
        p = jax.nn.softmax(jnp.concatenate([s_ctx, s_lat], axis=-1), axis=-1).astype(vb.dtype)
        p_ctx = p[..., :C]
        p_lat = p[..., C:].reshape(B, NA_HEADS, GRID_W, wr, GRID_W)
        return (jnp.einsum('bhqk,bkhd->bqhd', p_ctx, vc)
                + jnp.einsum('bhqrk,brkhd->bqhd', p_lat, vb))

    ol = lax.map(row_block, jnp.arange(n_rows))
    ol = jnp.moveaxis(ol, 0, 1).reshape(B, S, NA_HEADS * NA_HEAD_DIM)
    yl = ol @ w_o
    yc = None
    if with_ctx:
        s = jnp.einsum('bqhd,bkhd->bhqk', qc, kc).astype(jnp.float32) * scale
        p = jax.nn.softmax(s, axis=-1).astype(vc.dtype)
        oc = jnp.einsum('bhqk,bkhd->bqhd', p, vc)
        yc = oc.reshape(B, C, NA_HEADS * NA_HEAD_DIM) @ w_o
    return yl, yc


def setup_inputs(seed: int = 0) -> dict:
    key = jax.random.key(seed)
    kit = iter(list(jax.random.split(key, 40)))

    def nrm(shape, scale=1.0):
        return jax.random.normal(next(kit), shape, jnp.float32) * scale

    D = D_MODEL
    inp = {}
    inp['x'] = nrm((BATCH, SEQ, D))
    inp['c'] = nrm((BATCH, D))
    inp['ctx'] = nrm((BATCH, CTX_LEN, D))
    inp['c_ctx'] = nrm((D,))
    inp['ada_w1'] = nrm((DEPTH, D, ADA_RANK), D ** -0.5)
    inp['ada_w2'] = nrm((DEPTH, ADA_RANK, N_MOD * D), 0.5 * ADA_RANK ** -0.5)
    inp['ada_b'] = nrm((DEPTH, N_MOD * D), 0.02)
    inp['ln_g'] = 1.0 + nrm((DEPTH, 2, D), 0.02)
    inp['ln_b'] = nrm((DEPTH, 2, D), 0.02)
    inp['mlp_w1'] = nrm((DEPTH, D, D_FF), D ** -0.5)
    inp['mlp_w2'] = nrm((DEPTH, D_FF, D), DN_BETA * D_FF ** -0.5)
    inp['da_w_qkv'] = nrm((N_DA, D, 3 * D), D ** -0.5)
    inp['da_w_o'] = nrm((N_DA, DA_HEADS * DA_V_DIM, D), DN_BETA * (DA_HEADS * DA_V_DIM) ** -0.5)
    inp['da_lq1'] = nrm((N_DA, DA_QK_DIM), 0.1)
    inp['da_lk1'] = nrm((N_DA, DA_QK_DIM), 0.1)
    inp['da_lq2'] = nrm((N_DA, DA_QK_DIM), 0.1)
    inp['da_lk2'] = nrm((N_DA, DA_QK_DIM), 0.1)
    inp['da_sub_g'] = 1.0 + nrm((N_DA, DA_V_DIM), 0.02)
    inp['mla_w_down'] = nrm((N_MLA, D, MLA_Q_RANK + MLA_KV_RANK + MLA_ROPE), D ** -0.5)
    inp['mla_q_g'] = 1.0 + nrm((N_MLA, MLA_Q_RANK), 0.02)
    inp['mla_w_uq'] = nrm((N_MLA, MLA_Q_RANK, MLA_HEADS * (MLA_NOPE + MLA_ROPE)), MLA_Q_RANK ** -0.5)
    inp['mla_kv_g'] = 1.0 + nrm((N_MLA, MLA_KV_RANK), 0.02)
    inp['mla_w_ukv'] = nrm((N_MLA, MLA_KV_RANK, MLA_HEADS * (MLA_NOPE + MLA_V)), MLA_KV_RANK ** -0.5)
    inp['mla_w_o'] = nrm((N_MLA, MLA_HEADS * MLA_V, D), DN_BETA * (MLA_HEADS * MLA_V) ** -0.5)
    inp['na_w_qkv'] = nrm((N_NA, D, 3 * NA_HEADS * NA_HEAD_DIM), D ** -0.5)
    inp['na_w_o'] = nrm((N_NA, NA_HEADS * NA_HEAD_DIM, D), DN_BETA * (NA_HEADS * NA_HEAD_DIM) ** -0.5)
    inp['na_rpb'] = nrm((N_NA, NA_HEADS, 2 * NA_WIN_ROWS - 1, 2 * NA_WIN_COLS - 1), 0.1)
    return inp


def reference(x, c, ctx, c_ctx, ada_w1, ada_w2, ada_b, ln_g, ln_b, mlp_w1, mlp_w2,
              da_w_qkv, da_w_o, da_lq1, da_lk1, da_lq2, da_lk2, da_sub_g,
              mla_w_down, mla_q_g, mla_w_uq, mla_kv_g, mla_w_ukv, mla_w_o,
              na_w_qkv, na_w_o, na_rpb):
    S = x.shape[1]
    pos = jnp.arange(S)
    rows = pos // GRID_W
    cols = pos % GRID_W
    xl, xc = x, ctx
    for i in range(DEPTH):
        with_ctx = i < DEPTH - 1
        kind = i % N_MIXERS
        slot = i // N_MIXERS
        ml = modulation(c, ada_w1[i], ada_w2[i], ada_b[i])
        mc = modulation(c_ctx[None], ada_w1[i], ada_w2[i], ada_b[i])
        hl = xl * (1.0 + ml[:, 1]) + ml[:, 0]
        hc = xc * (1.0 + mc[:, 1]) + mc[:, 0]
        if kind == 0:
            lam_init = 0.8 - 0.6 * math.exp(-0.3 * i)
            yl, yc = diff_attention(hl, hc, da_w_qkv[slot], da_w_o[slot], da_lq1[slot], da_lk1[slot],
                                    da_lq2[slot], da_lk2[slot], da_sub_g[slot], lam_init,
                                    rows, cols, with_ctx)
        elif kind == 1:
            yl, yc = mla_attention(hl, hc, mla_w_down[slot], mla_q_g[slot], mla_w_uq[slot],
                                   mla_kv_g[slot], mla_w_ukv[slot], mla_w_o[slot],
                                   rows, cols, with_ctx)
        else:
            yl, yc = neighbourhood_attention(hl, hc, na_w_qkv[slot], na_w_o[slot], na_rpb[slot], with_ctx)
        xl = layer_norm(DN_ALPHA * xl + ml[:, 2] * yl, ln_g[i, 0], ln_b[i, 0])
        hl = xl * (1.0 + ml[:, 4]) + ml[:, 3]
        xl = layer_norm(DN_ALPHA * xl + ml[:, 5] * sq_relu_mlp(hl, mlp_w1[i], mlp_w2[i]),
                        ln_g[i, 1], ln_b[i, 1])
        if with_ctx:
            xc = layer_norm(DN_ALPHA * xc + mc[:, 2] * yc, ln_g[i, 0], ln_b[i, 0])
            hc = xc * (1.0 + mc[:, 4]) + mc[:, 3]
            xc = layer_norm(DN_ALPHA * xc + mc[:, 5] * sq_relu_mlp(hc, mlp_w1[i], mlp_w2[i]),
                            ln_g[i, 1], ln_b[i, 1])
    return xl
```

```cpp
#include <hip/hip_runtime.h>
#include <cstdio>
#include <cstdint>

#define GAS __attribute__((address_space(1)))
#define LAS __attribute__((address_space(3)))
typedef short s16x4 __attribute__((ext_vector_type(4)));
typedef float f32x16 __attribute__((ext_vector_type(16)));
typedef unsigned u32x2 __attribute__((ext_vector_type(2)));

#ifndef MK_ONE_LAUNCH
#define MK_ONE_LAUNCH 1
#endif

namespace cfg {
constexpr int D = 4096, NB = 2, SEQ = 4096, CTX = 256, DFF = 16384, DEPTH = 4;
constexpr int MLAT = NB * SEQ, MCTX = NB * CTX, MALL = MLAT + MCTX;
constexpr int ADA_R = 512, NMOD = 6;
constexpr float DN_ALPHA = 1.6817928305074290f;
constexpr float LN_EPS = 1e-5f, RMS_EPS = 1e-6f;
constexpr int MLA_QR = 1536, MLA_KVR = 512, MLA_DOWN = 2112, MLA_DOWN_PAD = 2304;
constexpr float LOG2E = 1.4426950408889634f;
constexpr size_t MiB = 1u << 20;
constexpr size_t WS_CTL = 0, CTL_ZERO_BYTES = 1 * MiB;
constexpr size_t WS_TAB = 1 * MiB;
constexpr size_t WS_TPART = 1 * MiB + 65536;
constexpr size_t WS_MOD = 2 * MiB;
constexpr size_t WS_W = 4 * MiB;
constexpr size_t SZ_WQKV = (size_t)12288 * 4096 * 2, SZ_WO = (size_t)4096 * 4096 * 2, SZ_WDOWN = (size_t)MLA_DOWN_PAD * 4096 * 2;
constexpr size_t SZ_WUQ = (size_t)12288 * 1536 * 2, SZ_WUKV = (size_t)16384 * 512 * 2, SZ_WOMLA = (size_t)4096 * 8192 * 2, SZ_W1 = (size_t)16384 * 4096 * 2;
constexpr size_t WS_WQKV_DA = WS_W;
constexpr size_t WS_WO_DA = WS_WQKV_DA + 2 * SZ_WQKV;
constexpr size_t WS_WDOWN = WS_WO_DA + 2 * SZ_WO;
constexpr size_t WS_WUQ = WS_WDOWN + SZ_WDOWN;
constexpr size_t WS_WUKV = WS_WUQ + SZ_WUQ;
constexpr size_t WS_WOMLA = WS_WUKV + SZ_WUKV;
constexpr size_t WS_WQKV_NA = WS_WOMLA + SZ_WOMLA;
constexpr size_t WS_WO_NA = WS_WQKV_NA + SZ_WQKV;
constexpr size_t WS_W1 = WS_WO_NA + SZ_WO;
constexpr size_t WS_W2 = WS_W1 + 4 * SZ_W1;
constexpr size_t WS_X = WS_W2 + 4 * SZ_W1;
constexpr size_t WS_H = WS_X + (size_t)MALL * D * 4;
constexpr size_t WS_QKV = WS_H + (size_t)MALL * D * 2;
constexpr size_t WS_BIG = WS_QKV + (size_t)MALL * 12288 * 2;
constexpr size_t WS_DOWN = WS_BIG + (size_t)MALL * 16384 * 2;
constexpr size_t WS_CQ = WS_DOWN + (size_t)MALL * MLA_DOWN_PAD * 4;
constexpr size_t WS_CKV = WS_CQ + (size_t)MALL * MLA_QR * 2;
constexpr size_t WS_KR = WS_CKV + (size_t)MALL * MLA_KVR * 2;
constexpr size_t WS_O = WS_KR + (size_t)MALL * 64 * 2;
constexpr size_t WS_STASH = WS_O + (size_t)MALL * 8192 * 2;
constexpr size_t WS_PART = WS_STASH + (size_t)256 * 32768 * 4;
constexpr size_t WS_STATS = WS_PART + (size_t)8 * 512 * 4096 * 4;
constexpr size_t WS_END = WS_STATS + (size_t)MALL * 2 * 4;
static_assert(WS_TPART + 4 * 8 * 3 * 512 * 4 <= WS_MOD && WS_MOD + 4 * 3 * 6 * 4096 * 4 <= WS_W, "ws map");
static_assert(WS_X % 256 == 0 && WS_END < (size_t)4200 * MiB, "ws map");
constexpr int LDSCTL_BYTES = 1024;
constexpr int RING_OFF = LDSCTL_BYTES, RING_BYTES = 147456;
constexpr int LDS_BYTES = RING_OFF + RING_BYTES;
constexpr int PH_CVT = 0, PH_MOD = 1, PH_INIT = 2, PH_L0 = 3, PH_PER_LAYER = 10, PH_END = PH_L0 + PH_PER_LAYER * DEPTH;
}
#define CAS __attribute__((address_space(4)))
typedef const CAS char* kptr_t;
__device__ __forceinline__ kptr_t karg_base() { kptr_t kp = (kptr_t)__builtin_amdgcn_kernarg_segment_ptr(); asm volatile("" : "+s"(kp)); return kp; }
#define INP(i) (*(const float* const CAS*)(karg_base() + 8 * (i)))
#define ARG_OUT() (*(float* const CAS*)(karg_base() + 216))
#define ARG_WS() (*(unsigned char* const CAS*)(karg_base() + 224))
typedef _Float16 h16_t;
__device__ __forceinline__ unsigned pk_h16(float a, float b) { return __builtin_bit_cast(unsigned, __builtin_amdgcn_cvt_pkrtz(a, b)); }
__device__ __forceinline__ float h16_lo(unsigned w) { return (float)__builtin_bit_cast(_Float16, (unsigned short)(w & 0xffffu)); }
__device__ __forceinline__ float h16_hi(unsigned w) { return (float)__builtin_bit_cast(_Float16, (unsigned short)(w >> 16)); }
namespace pg8 {
#define PG8_LAS __attribute__((address_space(3)))
typedef unsigned short bf16_t;
typedef short bf16x8 __attribute__((ext_vector_type(8)));
typedef float f32x4 __attribute__((ext_vector_type(4)));
typedef unsigned u32x4 __attribute__((ext_vector_type(4)));
constexpr int BM = 256, BK = 64, HALF = 128, HTB = HALF * BK * 2  , STAGE_BYTES = 8 * HTB, NXCD = 8, WGM = 8;

__host__ __device__ __forceinline__ int lds_byte(int r, int c) { const int st = (r >> 4) * 2 + (c >> 5), rr = r & 15, cc = c & 31, ob = rr * 64 + cc * 2; return st * 1024 + (ob ^ (((ob >> 9) & 1) << 5)); }
__host__ __device__ __forceinline__ void stage_rc(int b, int& R, int& C) { const int st = b / 1024, sb = b % 1024, swz = sb ^ (((sb >> 9) & 1) << 5); R = (st >> 1) * 16 + swz / 64; C = (st & 1) * 32 + (swz % 64) / 2; }
__host__ __device__ __forceinline__ int perm32(int rho) { const int n = rho >> 4, i = rho & 15; return 8 * (i >> 2) + 4 * n + (i & 3); }

struct Unit { int pm, pn, ks; };
struct Gemm { const bf16_t* A; const bf16_t* Bt; int M, N, K, lda, ldb; };

struct StaticOrder {
    int nM, nN, nwg, G, c;
    __host__ __device__ void init(int M, int N, int G_, int c_) { nM = M / BM; nN = N / BM; nwg = nM * nN; G = G_; c = c_; }
    __host__ __device__ bool next(int i, Unit& u) const {
        const int L = i * G + c; if (L >= nwg) return false;
        int wgid = L; { const int q = nwg / NXCD, r = nwg % NXCD, xcd = wgid % NXCD, off = wgid / NXCD; wgid = (xcd < r ? xcd * (q + 1) : r * (q + 1) + (xcd - r) * q) + off; }
        const int nig = WGM * nN, gid = wgid / nig, fm = gid * WGM, gsz = (nM - fm) < WGM ? (nM - fm) : WGM;
        u.pm = fm + ((wgid % nig) % gsz); u.pn = (wgid % nig) / gsz; u.ks = 0; return true;
    }
    __device__ __forceinline__ void a_ready(const Unit&) const {}
    __device__ __forceinline__ void done(const Unit&) const {}
};
struct SplitKOrder {
    int nM, nN, nS, G, c;
    __host__ __device__ void init(int M, int N, int nS_, int G_, int c_) { nM = M / BM; nN = N / BM; nS = nS_; G = G_; c = c_; }
    __host__ __device__ bool next(int i, Unit& u) const {
        const int L = i * G + c; if (L >= nM * nN * nS) return false;
        u.ks = L % nS; const int t = L / nS; u.pm = t % nM; u.pn = t / nM; return true;
    }
    __device__ __forceinline__ void a_ready(const Unit&) const {}
    __device__ __forceinline__ void done(const Unit&) const {}
};
__device__ __forceinline__ unsigned cvt_pk_bf16(float lo, float hi) { unsigned r; asm volatile("v_cvt_pk_bf16_f32 %0, %1, %2" : "=v"(r) : "v"(lo), "v"(hi)); return r; }
#ifndef EPI_NT
#define EPI_NT 0
#endif
#if EPI_NT
#define EPI_STORE(p, v) __builtin_nontemporal_store((v), (p))
#else
#define EPI_STORE(p, v) (*(p) = (v))
#endif
#define EPI_LOAD(p) __builtin_nontemporal_load(p)
template <int ACT  > struct EpiBf16 {
    static constexpr bool PERM = true, AFTER_DRAIN = false;
    bf16_t* O; int ldc;
    __device__ __forceinline__ void operator()(const f32x4 (&acc)[2][2][4][2], const Unit& u, int wr, int wc, int fr, int fq) const {
        const int row0 = u.pm * BM + wr * 64 + fr; const int col0 = u.pn * BM + wc * 32 + 8 * fq;
#pragma unroll
        for (int ai = 0; ai < 2; ++ai)
#pragma unroll
            for (int m = 0; m < 4; ++m) { bf16_t* rowp = O + (size_t)(row0 + ai * HALF + m * 16) * ldc + col0;
#pragma unroll
                for (int bj = 0; bj < 2; ++bj) { f32x4 v0 = acc[ai][bj][m][0], v1 = acc[ai][bj][m][1];
                    if (ACT == 1) {
#pragma unroll
                        for (int j = 0; j < 4; ++j) { const float a = fmaxf(v0[j], 0.f), b = fmaxf(v1[j], 0.f); v0[j] = a * a; v1[j] = b * b; } }
                    u32x4 w; w.x = cvt_pk_bf16(v0[0], v0[1]); w.y = cvt_pk_bf16(v0[2], v0[3]); w.z = cvt_pk_bf16(v1[0], v1[1]); w.w = cvt_pk_bf16(v1[2], v1[3]);
                    EPI_STORE((u32x4*)(rowp + bj * HALF), w); } }
    }
};
template <int KIND> struct EpiRope {
    static constexpr bool PERM = true, AFTER_DRAIN = false;
    bf16_t* O; int ldc; const float* tab; int rope_cols; int qcols; float qscale;
    __device__ __forceinline__ void operator()(const f32x4 (&acc)[2][2][4][2], const Unit& u, int wr, int wc, int fr, int fq) const {
        const int row0 = u.pm * BM + wr * 64 + fr; const int col0 = u.pn * BM + wc * 32 + 8 * fq;
        const bool lat = u.pm < 32;
        const float sgn = fq < 2 ? -1.f : 1.f;
        const float qs = (u.pn * BM < qcols) ? qscale : 1.f;
#pragma unroll
        for (int ai = 0; ai < 2; ++ai)
#pragma unroll
            for (int m = 0; m < 4; ++m) { const int row = row0 + ai * HALF + m * 16; bf16_t* rowp = O + (size_t)row * ldc + col0;
                const int s = row & 4095, pos = (wc & 1) ? (s & 63) : (s >> 6);
                const float* tp = tab + pos * 16 + 8 * (fq & 1);
                f32x4 c0 = {1.f, 1.f, 1.f, 1.f}, c1 = c0, s0 = {0.f, 0.f, 0.f, 0.f}, s1 = s0;
                if (lat) { c0 = *(const f32x4*)tp; c1 = *(const f32x4*)(tp + 4); s0 = *(const f32x4*)(tp + 1024); s1 = *(const f32x4*)(tp + 1028); }
#pragma unroll
                for (int bj = 0; bj < 2; ++bj) { f32x4 v0 = acc[ai][bj][m][0], v1 = acc[ai][bj][m][1];
                    const bool rope = lat && (KIND == 0 ? (u.pn * BM < rope_cols) : (((4 * u.pn + 2 * bj + (wc >> 1)) % 3) == 2));
                    if (rope) {
                        f32x4 p0, p1;
#pragma unroll
                        for (int j = 0; j < 4; ++j) { p0[j] = __shfl_xor(v0[j], 32); p1[j] = __shfl_xor(v1[j], 32); }
                        v0 = v0 * c0 + (p0 * s0) * sgn; v1 = v1 * c1 + (p1 * s1) * sgn; }
                    v0 = v0 * qs; v1 = v1 * qs;
                    u32x4 w; w.x = cvt_pk_bf16(v0[0], v0[1]); w.y = cvt_pk_bf16(v0[2], v0[3]); w.z = cvt_pk_bf16(v1[0], v1[1]); w.w = cvt_pk_bf16(v1[2], v1[3]);
                    EPI_STORE((u32x4*)(rowp + bj * HALF), w); } }
    }
};
struct EpiF32 {
    static constexpr bool PERM = false, AFTER_DRAIN = false;
    float* C; int ldc;
    __device__ __forceinline__ void operator()(const f32x4 (&acc)[2][2][4][2], const Unit& u, int wr, int wc, int fr, int fq) const {
        const int row0 = u.pm * BM + wr * 64 + fr, col0 = u.pn * BM + wc * 32 + 4 * fq;
#pragma unroll
        for (int ai = 0; ai < 2; ++ai)
#pragma unroll
            for (int m = 0; m < 4; ++m) { float* rowp = C + (size_t)(row0 + ai * HALF + m * 16) * ldc + col0;
#pragma unroll
                for (int bj = 0; bj < 2; ++bj)
#pragma unroll
                    for (int n = 0; n < 2; ++n) EPI_STORE((f32x4*)(rowp + bj * HALF + n * 16), acc[ai][bj][m][n]); }
    }
};
struct EpiResid {
    static constexpr bool PERM = true, AFTER_DRAIN = false;
    const float* gate; float alpha; int pln;
    __device__ __forceinline__ void operator()(const f32x4 (&acc)[2][2][4][2], const Unit& u, int wr, int wc, int fr, int fq) const {
        const int row0 = u.pm * BM + wr * 64 + fr, col0 = u.pn * BM + wc * 32 + 8 * fq;
        h16_t* X = (h16_t*)(ARG_WS() + cfg::WS_X); const float* stats = pln >= 0 ? (const float*)(ARG_WS() + cfg::WS_STATS) : nullptr;
        const float* lng = INP(7  ) + (size_t)(pln >= 0 ? pln : 0) * 4096; const float* lnb = INP(8  ) + (size_t)(pln >= 0 ? pln : 0) * 4096;
        const int cond = u.pm < 16 ? 0 : (u.pm < 32 ? 1 : 2);
        const float* gp = gate + (size_t)cond * (6 * 4096) + col0;
        f32x4 gv[2][2], lg[2][2], lb[2][2];
#pragma unroll
        for (int bj = 0; bj < 2; ++bj)
#pragma unroll
            for (int n = 0; n < 2; ++n) { gv[bj][n] = *(const f32x4*)(gp + bj * HALF + n * 4);
                if (stats) { lg[bj][n] = *(const f32x4*)(lng + col0 + bj * HALF + n * 4) * alpha; lb[bj][n] = *(const f32x4*)(lnb + col0 + bj * HALF + n * 4) * alpha; }
                else { lg[bj][n] = (f32x4){alpha, alpha, alpha, alpha}; lb[bj][n] = (f32x4){0.f, 0.f, 0.f, 0.f}; } }
        constexpr int EPI_PF = 1;
        const float* statp = (const float*)(ARG_WS() + cfg::WS_STATS);
        u32x4 zb[EPI_PF + 1][2]; float2 sb[EPI_PF + 1];
#define EPI_RS_LOAD(g_) do { const int row_ = row0 + ((g_) >> 2) * HALF + ((g_) & 3) * 16; const h16_t* rowi_ = X + (size_t)row_ * 4096 + col0; \
            sb[(g_) % (EPI_PF + 1)] = *(const float2*)(statp + 2 * row_);        \
            _Pragma("unroll") for (int bj = 0; bj < 2; ++bj) zb[(g_) % (EPI_PF + 1)][bj] = EPI_LOAD((const u32x4*)(rowi_ + bj * HALF)); } while (0)
#pragma unroll
        for (int g = 0; g < EPI_PF; ++g) EPI_RS_LOAD(g);
#pragma unroll
        for (int g = 0; g < 8; ++g) { const int ai = g >> 2, m = g & 3; const int row = row0 + ai * HALF + m * 16; h16_t* rowp = X + (size_t)row * 4096 + col0;
            if (g + EPI_PF < 8) EPI_RS_LOAD(g + EPI_PF);
            asm volatile("" ::: "memory"); __builtin_amdgcn_sched_barrier(0);
            const float mean = stats ? sb[g % (EPI_PF + 1)].x : 0.f, rstd = stats ? sb[g % (EPI_PF + 1)].y : 1.f;
#pragma unroll
            for (int bj = 0; bj < 2; ++bj) { const u32x4 zw = zb[g % (EPI_PF + 1)][bj];
                const f32x4 z0 = {h16_lo(zw.x), h16_hi(zw.x), h16_lo(zw.y), h16_hi(zw.y)}, z1 = {h16_lo(zw.z), h16_hi(zw.z), h16_lo(zw.w), h16_hi(zw.w)};
                const f32x4 o0 = ((z0 - mean) * rstd) * lg[bj][0] + lb[bj][0] + gv[bj][0] * acc[ai][bj][m][0];
                const f32x4 o1 = ((z1 - mean) * rstd) * lg[bj][1] + lb[bj][1] + gv[bj][1] * acc[ai][bj][m][1];
                u32x4 w; w.x = pk_h16(o0[0], o0[1]); w.y = pk_h16(o0[2], o0[3]); w.z = pk_h16(o1[0], o1[1]); w.w = pk_h16(o1[2], o1[3]);
                EPI_STORE((u32x4*)(rowp + bj * HALF), w); }
            asm volatile("" ::: "memory"); __builtin_amdgcn_sched_barrier(0); }
#undef EPI_RS_LOAD
    }
};
struct EpiSlabBf16 {
    static constexpr bool PERM = true, AFTER_DRAIN = false;
    bf16_t* P;
    __device__ __forceinline__ void operator()(const f32x4 (&acc)[2][2][4][2], const Unit& u, int wr, int wc, int fr, int fq) const {
        const int row0 = u.pm * BM + wr * 64 + fr; const int col0 = u.pn * BM + wc * 32 + 8 * fq;
        bf16_t* base = P + (size_t)u.ks * (512 * 4096);
#pragma unroll
        for (int ai = 0; ai < 2; ++ai)
#pragma unroll
            for (int m = 0; m < 4; ++m) { bf16_t* rowp = base + (size_t)(row0 + ai * HALF + m * 16) * 4096 + col0;
#pragma unroll
                for (int bj = 0; bj < 2; ++bj) { const f32x4 v0 = acc[ai][bj][m][0], v1 = acc[ai][bj][m][1];
                    u32x4 w; w.x = cvt_pk_bf16(v0[0], v0[1]); w.y = cvt_pk_bf16(v0[2], v0[3]); w.z = cvt_pk_bf16(v1[0], v1[1]); w.w = cvt_pk_bf16(v1[2], v1[3]);
                    *(u32x4*)(rowp + bj * HALF) = w; } }
    }
};
struct EpiSlab {
    static constexpr bool PERM = false, AFTER_DRAIN = false;
    float* P;
    __device__ __forceinline__ void operator()(const f32x4 (&acc)[2][2][4][2], const Unit& u, int wr, int wc, int fr, int fq) const {
        const int row0 = u.pm * BM + wr * 64 + fr, col0 = u.pn * BM + wc * 32 + 4 * fq;
        float* base = P + (size_t)u.ks * (512 * 4096);
#pragma unroll
        for (int ai = 0; ai < 2; ++ai)
#pragma unroll
            for (int m = 0; m < 4; ++m) { float* rowp = base + (size_t)(row0 + ai * HALF + m * 16) * 4096 + col0;
#pragma unroll
                for (int bj = 0; bj < 2; ++bj)
#pragma unroll
                    for (int n = 0; n < 2; ++n) EPI_STORE((f32x4*)(rowp + bj * HALF + n * 16), acc[ai][bj][m][n]); }
    }
};
template <class Epi, class Sched, bool ALIGN_EPI = false, bool SP2 = false>
__device__ __forceinline__ void gemm_phase(PG8_LAS unsigned char* lds, const Gemm g, const Sched& S, const Epi& E, const int wave_id_) {
    int wave_id = wave_id_; asm volatile("" : "+s"(wave_id));
    int tid; { unsigned m_ = ~0u; asm volatile("" : "+s"(m_)); tid = wave_id * 64 + (int)__builtin_amdgcn_mbcnt_hi(m_, __builtin_amdgcn_mbcnt_lo(m_, 0u)); } asm volatile("" : "+v"(tid));
    const int wid = wave_id, lane = tid & 63, wr = wid >> 2, wc = wid & 3, fr = lane & 15, fq = lane >> 4;
    const int K = g.K, nt = K / BK;
    unsigned voffA[2], voffB[2];
#pragma unroll
    for (int i = 0; i < 2; ++i) { int R, C; stage_rc(tid * 16 + i * 8192, R, C); const int Rb = Epi::PERM ? ((R & ~31) + perm32(R & 31)) : R;
        voffA[i] = (unsigned)(R * g.lda + C) * 2u; voffB[i] = (unsigned)(Rb * g.ldb + C) * 2u; }
    const size_t kstep = (size_t)(BK * 2);
    const size_t hstepA = (size_t)HALF * g.lda * 2, hstepB = (size_t)HALF * g.ldb * 2;
    const size_t tstepA = 2 * hstepA, tstepB = 2 * hstepB;
    const unsigned ldsw = (unsigned)wid * 1024u;
    const int aoff = lds_byte(wr * 64 + fr, fq * 8), boff = lds_byte(wc * 32 + fr, fq * 8);
#define PG8_SA(b, h) (((b) * 2 + (h)) * HTB)
#define PG8_SB(b, h) ((4 + (b) * 2 + (h)) * HTB)
#define PG8_STAGE(bufoff, gbase, voff) do { _Pragma("unroll") for (int _i = 0; _i < 2; ++_i) \
        __builtin_amdgcn_global_load_lds((const unsigned*)((const char*)(gbase) + (voff)[_i]), (PG8_LAS unsigned*)(lds + (bufoff) + ldsw + _i * 8192), 16, 0, 0); } while (0)
#define PG8_LDA(dst, b, h) do { _Pragma("unroll") for (int m = 0; m < 4; ++m) _Pragma("unroll") for (int k = 0; k < 2; ++k) dst[m][k] = *(const PG8_LAS bf16x8*)(lds + PG8_SA(b, h) + aoff + m * 2048 + k * 1024); } while (0)
#define PG8_LDB(dst, b, h) do { _Pragma("unroll") for (int n = 0; n < 2; ++n) _Pragma("unroll") for (int k = 0; k < 2; ++k) dst[n][k] = *(const PG8_LAS bf16x8*)(lds + PG8_SB(b, h) + boff + n * 2048 + k * 1024); } while (0)
#define PG8_MMA(ai, bj, At, Bt) do { __builtin_amdgcn_s_setprio(1); _Pragma("unroll") for (int m = 0; m < 4; ++m) _Pragma("unroll") for (int n = 0; n < 2; ++n) _Pragma("unroll") for (int k = 0; k < 2; ++k) \
        acc[ai][bj][m][n] = __builtin_amdgcn_mfma_f32_16x16x32_bf16(Bt[n][k], At[m][k], acc[ai][bj][m][n], 0, 0, 0); __builtin_amdgcn_s_setprio(0); } while (0)
#define PG8_WAIT_V(n) asm volatile("s_waitcnt vmcnt(" #n ")" ::: "memory")
#define PG8_WAIT_L(n) asm volatile("s_waitcnt lgkmcnt(" #n ")" ::: "memory")
#define PG8_BAR __builtin_amdgcn_s_barrier()
#define PG8_SCHED __builtin_amdgcn_sched_barrier(0)
    Unit cur, nxt; int ui = 0;
    if (!S.next(0, cur)) return;
    f32x4 acc[2][2][4][2];
#pragma unroll
    for (int a = 0; a < 2; ++a)
#pragma unroll
        for (int b = 0; b < 2; ++b)
#pragma unroll
            for (int m = 0; m < 4; ++m)
#pragma unroll
                for (int n = 0; n < 2; ++n) acc[a][b][m][n] = (f32x4){0.f, 0.f, 0.f, 0.f};
    bf16x8 At[4][2], B0[2][2], B1[2][2];
    const char* cA = (const char*)g.A + (size_t)cur.pm * tstepA + (size_t)cur.ks * K * 2; const char* cB = (const char*)g.Bt + (size_t)cur.pn * tstepB + (size_t)cur.ks * K * 2;
    S.a_ready(cur);
    if constexpr (SP2) {
        PG8_STAGE(PG8_SB(0, 0), cB, voffB); PG8_STAGE(PG8_SB(0, 1), cB + hstepB, voffB); PG8_STAGE(PG8_SA(0, 0), cA, voffA); PG8_STAGE(PG8_SA(0, 1), cA + hstepA, voffA);
        if (wr == 1) PG8_BAR;
        PG8_WAIT_V(2); PG8_BAR;
        PG8_STAGE(PG8_SB(1, 0), cB + kstep, voffB); PG8_STAGE(PG8_SA(1, 0), cA + kstep, voffA); PG8_STAGE(PG8_SB(1, 1), cB + hstepB + kstep, voffB);
        PG8_WAIT_V(6); PG8_BAR;
    } else {
        PG8_STAGE(PG8_SB(0, 0), cB, voffB); PG8_STAGE(PG8_SA(0, 0), cA, voffA); PG8_STAGE(PG8_SB(0, 1), cB + hstepB, voffB); PG8_STAGE(PG8_SA(0, 1), cA + hstepA, voffA);
        if (wr == 1) PG8_BAR;
        PG8_WAIT_V(4); PG8_BAR;
        PG8_STAGE(PG8_SB(1, 0), cB + kstep, voffB); PG8_STAGE(PG8_SA(1, 0), cA + kstep, voffA); PG8_STAGE(PG8_SB(1, 1), cB + hstepB + kstep, voffB);
        PG8_WAIT_V(6); PG8_BAR;
    }
    for (;;) {
        const bool has_next = S.next(ui + 1, nxt);
        const char* nA = has_next ? (const char*)g.A + (size_t)nxt.pm * tstepA + (size_t)nxt.ks * K * 2 : cA; const char* nB = has_next ? (const char*)g.Bt + (size_t)nxt.pn * tstepB + (size_t)nxt.ks * K * 2 : cB;
        for (int t = 0; t < nt; t += 2) {
            const bool last = (t == nt - 2);
            const char* a1 = cA + (size_t)(t + 1) * kstep;
            const char* a2 = last ? nA : cA + (size_t)(t + 2) * kstep; const char* b2 = last ? nB : cB + (size_t)(t + 2) * kstep;
            const char* a3 = a2 + kstep; const char* b3 = b2 + kstep;
            if (last && has_next) S.a_ready(nxt);
            if constexpr (SP2) {
            PG8_LDB(B0, 0, 0); PG8_LDB(B1, 0, 1); PG8_SCHED; PG8_LDA(At, 0, 0); PG8_STAGE(PG8_SA(1, 1), a1 + hstepA, voffA);
            PG8_WAIT_V(8); PG8_WAIT_L(0); PG8_BAR; PG8_MMA(0, 0, At, B0); PG8_MMA(0, 1, At, B1); PG8_BAR; PG8_SCHED;
            PG8_LDA(At, 0, 1); PG8_STAGE(PG8_SB(0, 0), b2, voffB); PG8_STAGE(PG8_SB(0, 1), b2 + hstepB, voffB); PG8_STAGE(PG8_SA(0, 0), a2, voffA);
            PG8_WAIT_V(8); PG8_WAIT_L(0); PG8_BAR; PG8_MMA(1, 0, At, B0); PG8_MMA(1, 1, At, B1); PG8_BAR; PG8_SCHED;
            PG8_LDB(B0, 1, 0); PG8_LDB(B1, 1, 1); PG8_SCHED; PG8_LDA(At, 1, 0); PG8_STAGE(PG8_SA(0, 1), a2 + hstepA, voffA);
            PG8_WAIT_V(8); PG8_WAIT_L(0); PG8_BAR; PG8_MMA(0, 0, At, B0); PG8_MMA(0, 1, At, B1); PG8_BAR; PG8_SCHED;
            PG8_LDA(At, 1, 1); PG8_STAGE(PG8_SB(1, 0), b3, voffB); PG8_STAGE(PG8_SB(1, 1), b3 + hstepB, voffB); PG8_STAGE(PG8_SA(1, 0), a3, voffA);
            PG8_WAIT_V(8); PG8_WAIT_L(0); PG8_BAR; PG8_MMA(1, 0, At, B0); PG8_MMA(1, 1, At, B1); PG8_BAR; PG8_SCHED;
            } else {
            PG8_LDB(B0, 0, 0); PG8_SCHED; PG8_LDA(At, 0, 0); PG8_STAGE(PG8_SA(1, 1), a1 + hstepA, voffA);
            PG8_WAIT_L(8); PG8_BAR; PG8_WAIT_L(0); PG8_MMA(0, 0, At, B0); PG8_BAR; PG8_SCHED;
            PG8_LDB(B1, 0, 1); PG8_STAGE(PG8_SB(0, 0), b2, voffB);
            PG8_BAR; PG8_WAIT_L(0); PG8_MMA(0, 1, At, B1); PG8_BAR;
            PG8_LDA(At, 0, 1); PG8_STAGE(PG8_SA(0, 0), a2, voffA);
            PG8_BAR; PG8_WAIT_L(0); PG8_MMA(1, 0, At, B0); PG8_BAR; PG8_SCHED;
            PG8_STAGE(PG8_SB(0, 1), b2 + hstepB, voffB);
            PG8_WAIT_V(6); PG8_BAR; PG8_MMA(1, 1, At, B1); PG8_BAR;
            PG8_LDB(B0, 1, 0); PG8_SCHED; PG8_LDA(At, 1, 0); PG8_STAGE(PG8_SA(0, 1), a2 + hstepA, voffA);
            PG8_WAIT_L(8); PG8_BAR; PG8_WAIT_L(0); PG8_MMA(0, 0, At, B0); PG8_BAR; PG8_SCHED;
            PG8_LDB(B1, 1, 1); PG8_STAGE(PG8_SB(1, 0), b3, voffB);
            PG8_BAR; PG8_WAIT_L(0); PG8_MMA(0, 1, At, B1); PG8_BAR;
            PG8_LDA(At, 1, 1); PG8_STAGE(PG8_SA(1, 0), a3, voffA);
            PG8_BAR; PG8_WAIT_L(0); PG8_MMA(1, 0, At, B0); PG8_BAR; PG8_SCHED;
            PG8_STAGE(PG8_SB(1, 1), b3 + hstepB, voffB);
            PG8_WAIT_V(6); PG8_BAR; PG8_MMA(1, 1, At, B1); PG8_BAR;
            }
        }
        if constexpr (ALIGN_EPI) { if (wr == 0) PG8_BAR; }
        if constexpr (!Epi::AFTER_DRAIN) { E(acc, cur, wr, wc, fr, fq); S.done(cur); }
        if (!has_next) break;
#pragma unroll
        for (int a = 0; a < 2; ++a)
#pragma unroll
            for (int b = 0; b < 2; ++b)
#pragma unroll
                for (int m = 0; m < 4; ++m)
#pragma unroll
                    for (int n = 0; n < 2; ++n) acc[a][b][m][n] = (f32x4){0.f, 0.f, 0.f, 0.f};
        cur = nxt; cA = nA; cB = nB; ++ui;
        if constexpr (ALIGN_EPI) { if (wr == 1) PG8_BAR; }
    }
    PG8_WAIT_V(0);
    if constexpr (!ALIGN_EPI) { if (wr == 0) PG8_BAR; }
    PG8_BAR;
    if constexpr (Epi::AFTER_DRAIN) { E.fused(acc, cur, wr, wc, fr, fq, lds, wid, lane); S.done(cur); }
#undef PG8_SA
#undef PG8_SB
#undef PG8_STAGE
#undef PG8_LDA
#undef PG8_LDB
#undef PG8_MMA
#undef PG8_WAIT_V
#undef PG8_WAIT_L
#undef PG8_BAR
#undef PG8_SCHED
}
}
#define XB_TMO      128
#define XB_XCNT(j)  (256  + 64 * (j))
#define XB_XSUB(j)  (1280 + 64 * (j))
#define XB_XGEN(j)  (2304 + 64 * (j))
#define XB_TOP      3328
#define XB_TOPGEN   3392
#define XCD_BAR_WORDS 3456
#define XB_SPIN_CAP (1u << 18)

__device__ __forceinline__ unsigned xb_ld(unsigned* p)              { return __hip_atomic_load(p, __ATOMIC_RELAXED, __HIP_MEMORY_SCOPE_AGENT); }
__device__ __forceinline__ unsigned xb_add(unsigned* p, unsigned v) { return __hip_atomic_fetch_add(p, v, __ATOMIC_RELAXED, __HIP_MEMORY_SCOPE_AGENT); }
__device__ __forceinline__ unsigned xb_xcc_id() { return (unsigned)__builtin_amdgcn_s_getreg((3 << 11) | 20) & 0xFu; }
#define XB_SPIN(cond, bar) do { unsigned _sp = 0; while (cond) { __builtin_amdgcn_s_sleep(1); \
    if ((++_sp & 255u) == 0u) { if (xb_ld(&(bar)[XB_TMO])) break; if (_sp > XB_SPIN_CAP) { atomicAdd(&(bar)[XB_TMO], 1u); break; } } } } while (0)

struct XcdBarrier {
    unsigned* bar; unsigned x;
    volatile LAS unsigned* st;
};

__device__ __forceinline__ XcdBarrier xcd_barrier_post(unsigned* bar, volatile LAS unsigned* st, const bool is_t0  ) {
    XcdBarrier b; b.bar = bar; b.x = xb_xcc_id(); b.st = st;
    if (is_t0) (void)xb_add(&bar[XB_XCNT(b.x)], 1u);
    return b;
}
__device__ __forceinline__ void xcd_barrier_complete(unsigned* bar, unsigned x, unsigned& nloc, unsigned& nx) {
    const unsigned G = gridDim.x * gridDim.y * gridDim.z;
    unsigned sum, cnt, mine, sp = 0u;
    for (;;) {
        sum = 0u; cnt = 0u; mine = 0u;
#pragma unroll
        for (unsigned j = 0; j < 16; ++j) { const unsigned c = xb_ld(&bar[XB_XCNT(j)]); sum += c; cnt += (c > 0u) ? 1u : 0u; mine = (j == x) ? c : mine; }
        if (sum == G) break;
        __builtin_amdgcn_s_sleep(1);
        if ((++sp & 255u) == 0u) { if (xb_ld(&bar[XB_TMO])) break; if (sp > XB_SPIN_CAP) { atomicAdd(&bar[XB_TMO], 1u); break; } }
    }
    nloc = mine > 0u ? mine : 1u; nx = cnt > 0u ? cnt : 1u;
}

__device__ __forceinline__ void xcd_barrier(const XcdBarrier& b, const bool is_t0  ) {
    asm volatile("s_waitcnt vmcnt(0)" ::: "memory");
    __syncthreads();
    if (is_t0) {
        unsigned* bar = b.bar;
        __builtin_amdgcn_s_waitcnt(0);
        unsigned nloc = b.st[0], nx = b.st[1];
        if (nloc == 0u) { xcd_barrier_complete(bar, b.x, nloc, nx); b.st[0] = nloc; b.st[1] = nx; }
        const unsigned old = xb_add(&bar[XB_XSUB(b.x)], 1u);
        const unsigned gen = old / nloc;
        if (old + 1u == (gen + 1u) * nloc) {
            __builtin_amdgcn_fence(__ATOMIC_RELEASE, "agent");
            asm volatile("s_waitcnt vmcnt(0)" ::: "memory");
            const unsigned og = xb_add(&bar[XB_TOP], 1u);
            const unsigned tg = og / nx;
            if (og + 1u == (tg + 1u) * nx) xb_add(&bar[XB_TOPGEN], 1u);
            else XB_SPIN(xb_ld(&bar[XB_TOPGEN]) == tg, bar);
            __builtin_amdgcn_fence(__ATOMIC_ACQUIRE, "agent");
            xb_add(&bar[XB_XGEN(b.x)], 1u);
            asm volatile("s_waitcnt vmcnt(0)" ::: "memory");
        } else {
            XB_SPIN(xb_ld(&bar[XB_XGEN(b.x)]) == gen, bar);
            __builtin_amdgcn_fence(__ATOMIC_ACQUIRE, "agent");
            asm volatile("s_waitcnt vmcnt(0)" ::: "memory");
        }
    }
    __syncthreads();
}
typedef unsigned short bf16_t;
typedef float f32x4 __attribute__((ext_vector_type(4)));
typedef short bf16x8 __attribute__((ext_vector_type(8)));
typedef unsigned u32x4 __attribute__((ext_vector_type(4)));
#define LDS_WAIT() asm volatile("s_waitcnt lgkmcnt(0)" ::: "memory")
#define VM_WAIT() asm volatile("s_waitcnt vmcnt(0)" ::: "memory")
#define SBAR() __builtin_amdgcn_sched_barrier(0)
#define NTL(p) __builtin_nontemporal_load(p)
__device__ __forceinline__ unsigned cvtpk(float lo, float hi) { unsigned r; asm volatile("v_cvt_pk_bf16_f32 %0, %1, %2" : "=v"(r) : "v"(lo), "v"(hi)); return r; }
__device__ __forceinline__ float wave_sum(float v) {
#pragma unroll
    for (int o = 1; o < 64; o <<= 1) v += __shfl_xor(v, o);
    return v;
}
__device__ __forceinline__ int lane_id_opq() { unsigned m = ~0u; asm volatile("" : "+s"(m)); return (int)__builtin_amdgcn_mbcnt_hi(m, __builtin_amdgcn_mbcnt_lo(m, 0u)); }
__device__ __forceinline__ float silu_f(float x) { return x / (1.f + __expf(-x)); }

__device__ __forceinline__ void cvt_matrix(const float* __restrict__ W, int K, int N, bf16_t* __restrict__ WT, LAS float* scr, int gw, int NGW, int lane, int it_lo, int it_hi) {
    const int nblk = N >> 6;
    const int lr = lane >> 4, lc = (lane & 15) * 4, c8 = lane & 7, nr = lane >> 3;
    int it = it_lo + gw;
    if (it >= it_hi) return;
#define CVT_SRC(IT) (W + (size_t)(((((IT) >> 3) / nblk) * 8 + ((IT) & 7)) * 64 + lr) * N + (((IT) >> 3) % nblk) * 64 + lc)
    f32x4 v[16];
    { const float* src = CVT_SRC(it);
#pragma unroll
      for (int i = 0; i < 16; ++i) v[i] = NTL((const f32x4*)(src + (size_t)(4 * i) * N)); }
    for (;;) {
        const int grp = it >> 3, kq = grp / nblk, nb = grp - kq * nblk, kb = kq * 8 + (it & 7), k0 = kb * 64, n0 = nb * 64;
#pragma unroll
        for (int i = 0; i < 16; ++i) { LAS float* d = scr + (4 * i + lr) * 65 + lc; d[0] = v[i][0]; d[1] = v[i][1]; d[2] = v[i][2]; d[3] = v[i][3]; }
        const int nit = it + NGW; const bool more = nit < it_hi;
        if (more) { const float* src = CVT_SRC(nit);
#pragma unroll
            for (int i = 0; i < 16; ++i) v[i] = NTL((const f32x4*)(src + (size_t)(4 * i) * N)); }
        LDS_WAIT();
#pragma unroll
        for (int j0 = 0; j0 < 8; j0 += 4) {
            float t[4][8];
#pragma unroll
            for (int j = 0; j < 4; ++j) { const LAS float* s = scr + (8 * c8) * 65 + nr + 8 * (j0 + j);
#pragma unroll
                for (int e = 0; e < 8; ++e) t[j][e] = s[e * 65]; }
            LDS_WAIT();
#pragma unroll
            for (int j = 0; j < 4; ++j) { const int n = nr + 8 * (j0 + j);
                u32x4 o; o.x = cvtpk(t[j][0], t[j][1]); o.y = cvtpk(t[j][2], t[j][3]); o.z = cvtpk(t[j][4], t[j][5]); o.w = cvtpk(t[j][6], t[j][7]);
                *(u32x4*)(WT + (size_t)(n0 + n) * K + k0 + 8 * c8) = o; } }
        if (!more) break;
        it = nit;
    }
#undef CVT_SRC
}

template <bool LAST>
__device__ __forceinline__ void ln_rows(int r_lo, int r_hi, int r_st, h16_t* Xb, bf16_t* Hb, float* outb, float* statb, const LAS float* lt, int lane,
                                        const bf16_t* partb, const float* gate, float alpha, bool prev_ln, const float* pg, const float* pb) {
    if (r_lo >= r_hi) return;
    u32x4 zr[8];
#define LN_LOADROW(R_) do { const u32x4* zp_ = (const u32x4*)(Xb + (size_t)(R_) * 4096) + lane; _Pragma("unroll") for (int j = 0; j < 8; ++j) zr[j] = NTL(&zp_[64 * j]); } while (0)
    LN_LOADROW(r_lo);
    for (int row = r_lo; row < r_hi; row += r_st) {
        float v[8][8];
#pragma unroll
        for (int j = 0; j < 8; ++j) { v[j][0] = h16_lo(zr[j].x); v[j][1] = h16_hi(zr[j].x); v[j][2] = h16_lo(zr[j].y); v[j][3] = h16_hi(zr[j].y);
            v[j][4] = h16_lo(zr[j].z); v[j][5] = h16_hi(zr[j].z); v[j][6] = h16_lo(zr[j].w); v[j][7] = h16_hi(zr[j].w); }
        if (row + r_st < r_hi) LN_LOADROW(row + r_st);
        float* st = statb + 2 * row;
        if (partb != nullptr && row >= cfg::MLAT) {
            float pm = 0.f, pr = 1.f; if (prev_ln) { pm = st[0]; pr = st[1]; }
            const bf16_t* part = partb + (size_t)(row - cfg::MLAT) * 4096;
#pragma unroll
            for (int j = 0; j < 8; ++j) { const int c0 = (lane + 64 * j) * 8;
                float acc[8] = {0.f, 0.f, 0.f, 0.f, 0.f, 0.f, 0.f, 0.f};
#pragma unroll
                for (int sl = 0; sl < 8; ++sl) { const u32x4 w = NTL((const u32x4*)(part + (size_t)sl * (512 * 4096) + c0));
                    acc[0] += __uint_as_float(w.x << 16); acc[1] += __uint_as_float(w.x & 0xffff0000u); acc[2] += __uint_as_float(w.y << 16); acc[3] += __uint_as_float(w.y & 0xffff0000u);
                    acc[4] += __uint_as_float(w.z << 16); acc[5] += __uint_as_float(w.z & 0xffff0000u); acc[6] += __uint_as_float(w.w << 16); acc[7] += __uint_as_float(w.w & 0xffff0000u); }
                const f32x4 g0 = *(const f32x4*)(gate + c0), g1 = *(const f32x4*)(gate + c0 + 4);
                f32x4 a0 = {1.f, 1.f, 1.f, 1.f}, a1 = a0, b0 = {0.f, 0.f, 0.f, 0.f}, b1 = b0;
                if (prev_ln) { a0 = *(const f32x4*)(pg + c0); a1 = *(const f32x4*)(pg + c0 + 4); b0 = *(const f32x4*)(pb + c0); b1 = *(const f32x4*)(pb + c0 + 4); }
#pragma unroll
                for (int e = 0; e < 8; ++e) { const float ge = e < 4 ? g0[e & 3] : g1[e & 3], ae = e < 4 ? a0[e & 3] : a1[e & 3], be = e < 4 ? b0[e & 3] : b1[e & 3];
                    float x = v[j][e]; if (prev_ln) x = ((x - pm) * pr) * ae + be;
                    v[j][e] = x * alpha + ge * acc[e]; }
                u32x4 zo; zo.x = pk_h16(v[j][0], v[j][1]); zo.y = pk_h16(v[j][2], v[j][3]); zo.z = pk_h16(v[j][4], v[j][5]); zo.w = pk_h16(v[j][6], v[j][7]);
                *((u32x4*)(Xb + (size_t)row * 4096) + lane + 64 * j) = zo; }
        }
        float s = 0.f;
#pragma unroll
        for (int j = 0; j < 8; ++j) s += ((v[j][0] + v[j][1]) + (v[j][2] + v[j][3])) + ((v[j][4] + v[j][5]) + (v[j][6] + v[j][7]));
        const float mean = wave_sum(s) * (1.f / 4096.f); float s2 = 0.f;
#pragma unroll
        for (int j = 0; j < 8; ++j)
#pragma unroll
            for (int e = 0; e < 8; ++e) { v[j][e] -= mean; s2 += v[j][e] * v[j][e]; }
        float eps_ = cfg::LN_EPS; asm volatile("" : "+s"(eps_));
        const float rstd = __builtin_amdgcn_rsqf(wave_sum(s2) * (1.f / 4096.f) + eps_);
        if (!LAST && lane == 0) { st[0] = mean; st[1] = rstd; }
        const int cond = row < cfg::SEQ ? 0 : (row < cfg::MLAT ? 1 : 2);
        const LAS f32x4* ta = (const LAS f32x4*)(lt + (size_t)(cond * 2) * 4096) + 2 * lane; const LAS f32x4* tb = ta + 1024;
#pragma unroll
        for (int j = 0; j < 8; ++j) { const f32x4 ga0 = ta[128 * j], ga1 = ta[128 * j + 1], gb0 = tb[128 * j], gb1 = tb[128 * j + 1];
            float h[8];
#pragma unroll
            for (int e = 0; e < 8; ++e) h[e] = (v[j][e] * rstd) * (e < 4 ? ga0[e & 3] : ga1[e & 3]) + (e < 4 ? gb0[e & 3] : gb1[e & 3]);
            if (LAST) { f32x4* op = (f32x4*)(outb + (size_t)row * 4096) + 2 * (lane + 64 * j); op[0] = (f32x4){h[0], h[1], h[2], h[3]}; op[1] = (f32x4){h[4], h[5], h[6], h[7]}; }
            else { u32x4 w; w.x = cvtpk(h[0], h[1]); w.y = cvtpk(h[2], h[3]); w.z = cvtpk(h[4], h[5]); w.w = cvtpk(h[6], h[7]); *((u32x4*)(Hb + (size_t)row * 4096) + lane + 64 * j) = w; } }
    }
#undef LN_LOADROW
}
__device__ __forceinline__ void init_row(const float* srow, h16_t* xrow, bf16_t* hrow, const float* sc, const float* sh, int lane) {
#pragma unroll
    for (int j = 0; j < 16; ++j) {
        const f32x4 x = NTL(&((const f32x4*)srow)[lane + 64 * j]);
        if (xrow) { u32x2 zo_; zo_.x = pk_h16(x[0], x[1]); zo_.y = pk_h16(x[2], x[3]); ((u32x2*)xrow)[lane + 64 * j] = zo_; }
        const f32x4 scv = ((const f32x4*)sc)[lane + 64 * j], shv = ((const f32x4*)sh)[lane + 64 * j];
        const f32x4 h = x * (scv + 1.f) + shv; u32x2 w; w.x = cvtpk(h[0], h[1]); w.y = cvtpk(h[2], h[3]);
        ((u32x2*)hrow)[lane + 64 * j] = w;
    }
}
__device__ __forceinline__ void mla_norm_row(const float* drow, bf16_t* cq, bf16_t* ckv, bf16_t* kr, const float* qg, const float* kvg, const float* tab, int row, int lane) {
    f32x4 a[6], c[2]; float sa = 0.f, sc = 0.f;
#pragma unroll
    for (int j = 0; j < 6; ++j) { a[j] = NTL(&((const f32x4*)drow)[lane + 64 * j]); sa += (a[j][0] * a[j][0] + a[j][1] * a[j][1]) + (a[j][2] * a[j][2] + a[j][3] * a[j][3]); }
#pragma unroll
    for (int j = 0; j < 2; ++j) { c[j] = NTL(&((const f32x4*)(drow + 1536))[lane + 64 * j]); sc += (c[j][0] * c[j][0] + c[j][1] * c[j][1]) + (c[j][2] * c[j][2] + c[j][3] * c[j][3]); }
    float kv = drow[2048 + lane];
    const float ra = __builtin_amdgcn_rsqf(wave_sum(sa) * (1.f / 1536.f) + cfg::RMS_EPS), rc = __builtin_amdgcn_rsqf(wave_sum(sc) * (1.f / 512.f) + cfg::RMS_EPS);
#pragma unroll
    for (int j = 0; j < 6; ++j) { const f32x4 g = ((const f32x4*)qg)[lane + 64 * j]; const f32x4 y = a[j] * ra * g; u32x2 w; w.x = cvtpk(y[0], y[1]); w.y = cvtpk(y[2], y[3]); ((u32x2*)cq)[lane + 64 * j] = w; }
#pragma unroll
    for (int j = 0; j < 2; ++j) { const f32x4 g = ((const f32x4*)kvg)[lane + 64 * j]; const f32x4 y = c[j] * rc * g; u32x2 w; w.x = cvtpk(y[0], y[1]); w.y = cvtpk(y[2], y[3]); ((u32x2*)ckv)[lane + 64 * j] = w; }
    const float pv = __shfl_xor(kv, 16);
    if (row < cfg::MLAT) { const int s = row & 4095, pos = (lane & 32) ? (s & 63) : (s >> 6); const float cs = tab[pos * 16 + (lane & 15)], sn = tab[1024 + pos * 16 + (lane & 15)];
        kv = kv * cs + ((lane & 16) ? pv : -pv) * sn; }
    const float hi = __shfl_down(kv, 1);
    if ((lane & 1) == 0) ((unsigned*)kr)[lane >> 1] = cvtpk(kv, hi);
}
#ifdef PROBE_VAR
#define ATT_PROBE_SIMPLE 1
#else
#define ATT_PROBE_SIMPLE 0
#endif
#ifndef ATT_SKEW1
#define ATT_SKEW1 0
#endif
#ifndef ATT_SIMPLE2
#define ATT_SIMPLE2 1
#endif
#ifndef ATT_EXCL
#define ATT_EXCL 0
#endif
namespace att {
constexpr int LDS_RING = 0, LDS_WS = 131072, LDS_BIAS = LDS_WS + 2048, LDS_END = LDS_BIAS + 4096;
constexpr float THR2 = 8.f * 1.4426950408889634f;
__device__ __forceinline__ int lane_opq() { unsigned m = ~0u; asm volatile("" : "+s"(m)); return (int)__builtin_amdgcn_mbcnt_hi(m, __builtin_amdgcn_mbcnt_lo(m, 0u)); }
__device__ __forceinline__ int crow(int r, int hi) { return (r & 3) + 8 * (r >> 2) + 4 * hi; }
__device__ __forceinline__ int v_st(int k, int c) { const int kk = (k & ~0xC) | ((k & 4) << 1) | ((k & 8) >> 1); return ((kk >> 3) * 4 + (c >> 5)) * 512 + ((kk & 7) * 32 + (c & 31)) * 2; }
__device__ __forceinline__ int v_rd_base(int lane) { return ((lane & 3) << 3) | (((lane >> 2) & 3) << 6) | (((lane >> 4) & 1) << 5) | (((lane >> 5) & 1) << 8); }
constexpr int v_rd_off(int d0, int ks, int half) { return d0 * 512 + ks * 4096 + half * 2048; }
typedef short v4i16_t __attribute__((ext_vector_type(4)));
template <int OFF> __device__ __forceinline__ s16x4 tr_read(const LAS unsigned char* vb) {
    return __builtin_bit_cast(s16x4, __builtin_amdgcn_ds_read_tr16_b64_v4i16((LAS v4i16_t*)(vb + OFF)));
}
template <int OFF> __device__ __forceinline__ bf16x8 k_read_asm(unsigned a) {
    bf16x8 r; asm volatile("ds_read_b128 %0, %1 offset:%2" : "=v"(r) : "v"(a), "i"(OFF) : "memory"); return r;
}
template <int OFF> __device__ __forceinline__ s16x4 tr_read_asm(unsigned vb) {
    s16x4 r; asm volatile("ds_read_b64_tr_b16 %0, %1 offset:%2" : "=&v"(r) : "v"(vb), "i"(OFF) : "memory"); return r;
}
template <int D0, bool VIS> __device__ __forceinline__ void pv_one(f32x16& od, const LAS unsigned char* vb, bf16x8 pa0, bf16x8 pa1, bf16x8 pa2, bf16x8 pa3) {
    s16x4 l0, h0, l1, h1, l2, h2, l3, h3;
    if constexpr (VIS) {
        l0 = tr_read<v_rd_off(D0, 0, 0)>(vb); h0 = tr_read<v_rd_off(D0, 0, 1)>(vb); l1 = tr_read<v_rd_off(D0, 1, 0)>(vb); h1 = tr_read<v_rd_off(D0, 1, 1)>(vb);
        l2 = tr_read<v_rd_off(D0, 2, 0)>(vb); h2 = tr_read<v_rd_off(D0, 2, 1)>(vb); l3 = tr_read<v_rd_off(D0, 3, 0)>(vb); h3 = tr_read<v_rd_off(D0, 3, 1)>(vb);
    } else {
        const unsigned vu = (unsigned)(uintptr_t)vb;
        l0 = tr_read_asm<v_rd_off(D0, 0, 0)>(vu); h0 = tr_read_asm<v_rd_off(D0, 0, 1)>(vu); l1 = tr_read_asm<v_rd_off(D0, 1, 0)>(vu); h1 = tr_read_asm<v_rd_off(D0, 1, 1)>(vu);
        l2 = tr_read_asm<v_rd_off(D0, 2, 0)>(vu); h2 = tr_read_asm<v_rd_off(D0, 2, 1)>(vu); l3 = tr_read_asm<v_rd_off(D0, 3, 0)>(vu); h3 = tr_read_asm<v_rd_off(D0, 3, 1)>(vu);
        asm volatile("s_waitcnt lgkmcnt(0)" ::: "memory"); SBAR();
    }
#define ATT_PK(L, H) (bf16x8){L[0], L[1], L[2], L[3], H[0], H[1], H[2], H[3]}
    od = __builtin_amdgcn_mfma_f32_32x32x16_bf16(pa0, ATT_PK(l0, h0), od, 0, 0, 0);
    od = __builtin_amdgcn_mfma_f32_32x32x16_bf16(pa1, ATT_PK(l1, h1), od, 0, 0, 0);
    od = __builtin_amdgcn_mfma_f32_32x32x16_bf16(pa2, ATT_PK(l2, h2), od, 0, 0, 0);
    od = __builtin_amdgcn_mfma_f32_32x32x16_bf16(pa3, ATT_PK(l3, h3), od, 0, 0, 0);
#undef ATT_PK
}
template <int DQK> __device__ __forceinline__ int kswg(int row) { return DQK == 128 ? (row & 15) : ((row >> 1) & 7); }
template <int DQK> __device__ __forceinline__ int kswz(int row, int colB) { return row * (DQK * 2) + (colB ^ (kswg<DQK>(row) << 4)); }

struct Src {
    const bf16_t* Q; int ldq;
    const bf16_t* K1; int ldk1;
    const bf16_t* K2; int ldk2;
    const bf16_t* V; int ldv;
    int ctx_row0, lat_row0;
    int NT;
};
template <int DQK, int MODE>
__device__ __forceinline__ void attn_core(const Src& S, float C  , LAS unsigned char* lds, f32x16 (&o)[4], float& l_reg, const int wave_id_, const int var_  ,
                                          int na_r  , int na_krlo, int na_c  ) {
    constexpr int NQ = DQK / 16, KCH = DQK / 8, KPT = KCH / 8  , KBUF = 64 * DQK * 2;
    constexpr int NS = (DQK == 192) ? 3 : 4, SS = 16384 + KBUF, IPT = 2 + KPT;
    static_assert(NS * SS <= LDS_WS, "attention ring");
    int wave_id = wave_id_; asm volatile("" : "+s"(wave_id));
    int lane = lane_opq(); asm volatile("" : "+v"(lane));
    float NEGBIG = -1e30f; asm volatile("" : "+s"(NEGBIG));
    const int wid = wave_id, r32 = lane & 31, hi = lane >> 5;
    LAS unsigned char* ring = lds + LDS_RING;
    LAS float* wsf = (LAS float*)(lds + LDS_WS) + wid * 64; LAS float* al_l = wsf + 32;
    float m_reg = NEGBIG; l_reg = 0.f;
#pragma unroll
    for (int d = 0; d < 4; ++d)
#pragma unroll
        for (int r = 0; r < 16; ++r) o[d][r] = 0.f;
    bf16x8 qr[NQ];
    { const bf16_t* Qw = S.Q + (size_t)(wid * 32 + r32) * S.ldq + hi * 8;
#pragma unroll
      for (int d0 = 0; d0 < NQ; ++d0) qr[d0] = *(const bf16x8*)(Qw + d0 * 16); }
    int voffV[2]; int koff[KPT]; bool k2[KPT];
#pragma unroll
    for (int i = 0; i < 2; ++i) { const int q = i * 512 + wid * 64 + lane, sub = q >> 5, within = q & 31, kk = (sub >> 2) * 8 + (within >> 2), c = (sub & 3) * 32 + (within & 3) * 8;
        const int k = ATT_SIMPLE2 ? kk : ((kk & ~0xC) | ((kk & 4) << 1) | ((kk & 8) >> 1)); voffV[i] = k * S.ldv + c; }
#pragma unroll
    for (int i = 0; i < KPT; ++i) { const int q = i * 512 + wid * 64 + lane, row = q / KCH, cpos = q - row * KCH, col = (cpos ^ kswg<DQK>(row)) * 8;
        k2[i] = (DQK == 192) && col >= 128; koff[i] = k2[i] ? row * S.ldk2 + (col - 128) : row * S.ldk1 + col; }
    const LAS unsigned char* vb0 = ring + v_rd_base(lane);
    constexpr int NKB = (DQK == 128) ? 8 : 4;
    int kb4[NKB];
#pragma unroll
    for (int i = 0; i < NKB; ++i) kb4[i] = kswz<DQK>(r32, (i * 16 + hi * 8) * 2);
#define ATT_ROW0(j) ((j) < 4 ? S.ctx_row0 + 64 * (j) : S.lat_row0 + 64 * ((j) - 4))
#define ATT_ISSUE(T) do { const int _r0 = ATT_ROW0(T); LAS unsigned char* _st = ring + ((T) % NS) * SS + wid * 1024; \
        const bf16_t* _vb = S.V + (size_t)_r0 * S.ldv; const bf16_t* _k1 = S.K1 + (size_t)_r0 * S.ldk1; const bf16_t* _k2 = (DQK == 192) ? S.K2 + (size_t)_r0 * S.ldk2 : _k1; \
        _Pragma("unroll") for (int _i = 0; _i < 2; ++_i) __builtin_amdgcn_global_load_lds((const unsigned*)(_vb + voffV[_i]), (LAS unsigned*)(_st + _i * 8192), 16, 0, 0); \
        _Pragma("unroll") for (int _i = 0; _i < KPT; ++_i) __builtin_amdgcn_global_load_lds((const unsigned*)((k2[_i] ? _k2 : _k1) + koff[_i]), (LAS unsigned*)(_st + 16384 + _i * 8192), 16, 0, 0); } while (0)
#define ATT_VMWAIT(N) asm volatile("s_waitcnt vmcnt(%0)" :: "n"(N) : "memory")
#define ATT_BAR() asm volatile("s_waitcnt lgkmcnt(0)\n\ts_barrier" ::: "memory")
#define ATT_SG(mask, n, id) __builtin_amdgcn_sched_group_barrier(mask, n, id)
    const int NT = S.NT;
#define ATT_ACTIVE(j) true
    int na_r0 = na_r - 4; na_r0 = na_r0 < 0 ? 0 : (na_r0 > 56 ? 56 : na_r0);
    int na_cs = na_c - 8; na_cs = na_cs < 0 ? 0 : (na_cs > 48 ? 48 : na_cs);
#define ATT_QKT(P0, P1, j) do { const LAS unsigned char* Kb = ring + ((j) % NS) * SS + 16384; \
        _Pragma("unroll") for (int r = 0; r < 16; ++r) { P0[r] = 0.f; P1[r] = 0.f; } \
        _Pragma("unroll") for (int d0 = 0; d0 < NQ; ++d0) { const LAS unsigned char* kp = Kb + kb4[d0 % NKB] + (d0 / NKB) * (NKB * 32); \
            const bf16x8 k0 = *(const LAS bf16x8*)kp, k1 = *(const LAS bf16x8*)(kp + 32 * DQK * 2); \
            P0 = __builtin_amdgcn_mfma_f32_32x32x16_bf16(k0, qr[d0], P0, 0, 0, 0); \
            P1 = __builtin_amdgcn_mfma_f32_32x32x16_bf16(k1, qr[d0], P1, 0, 0, 0); \
            if (NQ > 8 && (d0 & 3) == 3 && d0 + 1 < NQ) SBAR(); } } while (0)
#define ATT_PART_A(P0, P1, j) do { \
        if (MODE == 1 && (j) >= 4) { const int kr = na_krlo + (j) - 4; const int cs_eff = (kr >= na_r0 && kr < na_r0 + 8) ? na_cs : 64; \
            const LAS float* bt = (const LAS float*)(lds + LDS_BIAS) + 64 + (kr - na_r + 7) * 32 + (15 - na_c) + 4 * hi; \
            _Pragma("unroll") for (int r = 0; r < 16; ++r) { const int kc0 = (r & 3) + 8 * (r >> 2); \
                const float b0 = bt[kc0], b1 = bt[kc0 + 32]; const int k0c = kc0 + 4 * hi - cs_eff, k1c = k0c + 32; \
                P0[r] = ((unsigned)k0c < 16u) ? fmaf(P0[r], C, b0) : NEGBIG; P1[r] = ((unsigned)k1c < 16u) ? fmaf(P1[r], C, b1) : NEGBIG; } } \
        pmax_ = fmaxf(P0[0], P1[0]); \
        _Pragma("unroll") for (int r = 1; r < 16; ++r) pmax_ = fmaxf(fmaxf(pmax_, P0[r]), P1[r]); \
        { auto rr = __builtin_amdgcn_permlane32_swap(__float_as_uint(pmax_), __float_as_uint(pmax_), false, false); pmax_ = fmaxf(__uint_as_float(rr[0]), __uint_as_float(rr[1])); } } while (0)
#define ATT_PART_B(P0, P1, AL, j) do { \
        const float CC = (MODE == 1 && (j) >= 4) ? 1.f : C; pmax_ *= CC; \
        { const bool keep_ = __all(pmax_ - m_reg <= THR2); const float mn = keep_ ? m_reg : fmaxf(m_reg, pmax_); AL = __builtin_amdgcn_exp2f(m_reg - mn); m_reg = mn; }     \
        const float nm = -m_reg; \
        _Pragma("unroll") for (int r = 0; r < 16; ++r) P0[r] = __builtin_amdgcn_exp2f(fmaf(P0[r], CC, nm)); } while (0)
#define ATT_PART_C(P0, P1, j) do { \
        const float CC = (MODE == 1 && (j) >= 4) ? 1.f : C; const float nm = -m_reg; \
        _Pragma("unroll") for (int r = 0; r < 16; ++r) { P1[r] = fmaf(P1[r], CC, nm); if (EXP_EARLY) P1[r] = __builtin_amdgcn_exp2f(P1[r]); } } while (0)
#define ATT_PARTIAL(P0, P1, AL, j) do { ATT_PART_A(P0, P1, j); ATT_PART_B(P0, P1, AL, j); ATT_PART_C(P0, P1, j); } while (0)
#define ATT_PK4(P, BASE, OUT) do { unsigned a0 = cvtpk(P[BASE + 0], P[BASE + 1]), a1 = cvtpk(P[BASE + 2], P[BASE + 3]); \
        unsigned b0 = cvtpk(P[BASE + 4], P[BASE + 5]), b1 = cvtpk(P[BASE + 6], P[BASE + 7]); \
        auto r0 = __builtin_amdgcn_permlane32_swap(a0, b0, false, false); auto r1 = __builtin_amdgcn_permlane32_swap(a1, b1, false, false); \
        u32x4 w = {r0[0], r1[0], r0[1], r1[1]}; OUT = *reinterpret_cast<bf16x8*>(&w); } while (0)
#define ATT_FINISH(P0, P1, AL) do { float ps = 0.f; \
        _Pragma("unroll") for (int r = 0; r < 16; ++r) { if (!EXP_EARLY) P1[r] = __builtin_amdgcn_exp2f(P1[r]); ps += P0[r] + P1[r]; } \
        { auto rr = __builtin_amdgcn_permlane32_swap(__float_as_uint(ps), __float_as_uint(ps), false, false); ps = __uint_as_float(rr[0]) + __uint_as_float(rr[1]); } \
        l_reg = l_reg * AL + ps; \
        ATT_PK4(P0, 0, pa0); ATT_PK4(P0, 8, pa1); ATT_PK4(P1, 0, pa2); ATT_PK4(P1, 8, pa3); } while (0)
#define ATT_RESC(AL) do { if (__any((AL) < 1.f)) { if (hi == 0) al_l[r32] = (AL); LDS_WAIT(); \
        _Pragma("unroll") for (int r = 0; r < 16; ++r) { const float a_ = al_l[crow(r, hi)]; _Pragma("unroll") for (int d = 0; d < 4; ++d) o[d][r] *= a_; } } } while (0)
#define ATT_PV1(j, D0) do { const LAS unsigned char* vb = vb0 + ((j) % NS) * SS; pv_one<D0, (!ATT_SKEW1 && !ATT_PROBE_SIMPLE && DQK == 64)>(o[D0], vb, pa0, pa1, pa2, pa3); } while (0)
#define ATT_TRR(k) do { constexpr int d0_ = ((k) >> 2), ks_ = ((k) & 3); trl[(k) % 3] = tr_read_asm<v_rd_off(d0_, ks_, 0)>(vbu_); trh[(k) % 3] = tr_read_asm<v_rd_off(d0_, ks_, 1)>(vbu_); } while (0)
#define ATT_MM(k) do { const s16x4 L_ = trl[(k) % 3], H_ = trh[(k) % 3]; const bf16x8 vf_ = (bf16x8){L_[0], L_[1], L_[2], L_[3], H_[0], H_[1], H_[2], H_[3]}; \
        o[(k) >> 2] = __builtin_amdgcn_mfma_f32_32x32x16_bf16(((k) & 3) == 0 ? pa0 : ((k) & 3) == 1 ? pa1 : ((k) & 3) == 2 ? pa2 : pa3, vf_, o[(k) >> 2], 0, 0, 0); } while (0)
#define ATT_MAX2(P0, P1, r) do { pmax_ = fmaxf(fmaxf(pmax_, P0[r]), P1[r]); pmax_ = fmaxf(fmaxf(pmax_, P0[(r) + 1]), P1[(r) + 1]); } while (0)
#define ATT_EXPR(P0, P1, r) do { P0[r] = __builtin_amdgcn_exp2f(fmaf(P0[r], C, nm_)); P1[r] = __builtin_amdgcn_exp2f(fmaf(P1[r], C, nm_)); } while (0)
#define ATT_CHUNK(k, WAITN, VALU_CODE) do { if ((k) + 2 < 16) ATT_TRR((k) + 2); asm volatile("s_waitcnt lgkmcnt(" #WAITN ")" ::: "memory"); SBAR(); ATT_MM(k); VALU_CODE; SBAR(); } while (0)
#define ATT_PVX(j, P0, P1, AL, HASN_) do { const unsigned vbu_ = (unsigned)(uintptr_t)(vb0 + ((j) % NS) * SS); s16x4 trl[3], trh[3]; float nm_ = 0.f; \
        ATT_TRR(0); ATT_TRR(1); \
        if (HASN_) pmax_ = fmaxf(P0[0], P1[0]); \
        ATT_CHUNK(0, 4, if (HASN_) { pmax_ = fmaxf(fmaxf(pmax_, P0[1]), P1[1]); }); \
        ATT_CHUNK(1, 4, if (HASN_) ATT_MAX2(P0, P1, 2)); ATT_CHUNK(2, 4, if (HASN_) ATT_MAX2(P0, P1, 4)); ATT_CHUNK(3, 4, if (HASN_) ATT_MAX2(P0, P1, 6)); \
        ATT_CHUNK(4, 4, if (HASN_) ATT_MAX2(P0, P1, 8)); ATT_CHUNK(5, 4, if (HASN_) ATT_MAX2(P0, P1, 10)); ATT_CHUNK(6, 4, if (HASN_) ATT_MAX2(P0, P1, 12)); ATT_CHUNK(7, 4, if (HASN_) ATT_MAX2(P0, P1, 14)); \
        ATT_CHUNK(8, 4, if (HASN_) { auto rr = __builtin_amdgcn_permlane32_swap(__float_as_uint(pmax_), __float_as_uint(pmax_), false, false); pmax_ = fmaxf(__uint_as_float(rr[0]), __uint_as_float(rr[1])) * C; \
            const bool keep_ = __all(pmax_ - m_reg <= THR2); const float mn = keep_ ? m_reg : fmaxf(m_reg, pmax_); AL = __builtin_amdgcn_exp2f(m_reg - mn); m_reg = mn; nm_ = -mn; }); \
        ATT_CHUNK(9, 4, if (HASN_) { ATT_EXPR(P0, P1, 0); ATT_EXPR(P0, P1, 1); ATT_EXPR(P0, P1, 2); }); \
        ATT_CHUNK(10, 4, if (HASN_) { ATT_EXPR(P0, P1, 3); ATT_EXPR(P0, P1, 4); }); ATT_CHUNK(11, 4, if (HASN_) { ATT_EXPR(P0, P1, 5); ATT_EXPR(P0, P1, 6); }); \
        ATT_CHUNK(12, 4, if (HASN_) { ATT_EXPR(P0, P1, 7); ATT_EXPR(P0, P1, 8); }); ATT_CHUNK(13, 4, if (HASN_) { ATT_EXPR(P0, P1, 9); ATT_EXPR(P0, P1, 10); }); \
        ATT_CHUNK(14, 2, if (HASN_) { ATT_EXPR(P0, P1, 11); ATT_EXPR(P0, P1, 12); }); ATT_CHUNK(15, 0, if (HASN_) { ATT_EXPR(P0, P1, 13); ATT_EXPR(P0, P1, 14); ATT_EXPR(P0, P1, 15); }); \
    } while (0)
#define ATT_STEP(PC0, PC1, ALC, PN0, PN1, ALN, j, HASN) do { \
        if (!(var_ & 16)) ATT_BAR(); \
        if (!(var_ & 8)) { if ((j) + NS - 1 < NT) ATT_ISSUE((j) + NS - 1); } \
        const bool actC = ATT_ACTIVE(j), actN = HASN && ATT_ACTIVE((j) + 1); \
        SBAR(); if (actN && !(var_ & 4)) ATT_QKT(PN0, PN1, (j) + 1); \
        if (actC && !(var_ & 1)) ATT_FINISH(PC0, PC1, ALC); \
        if (DQK == 64 && !ATT_PROBE_SIMPLE) { ATT_SG(0x100, 4, 0); _Pragma("unroll") for (int g_ = 0; g_ < 2 * NQ; ++g_) { ATT_SG(0x008, 1, 0); ATT_SG(0x100, 1, 0); ATT_SG(0x002, 8, 0); } } \
        SBAR(); \
        if (DQK == 64 && !ATT_PROBE_SIMPLE) { \
            ATT_PVX(j, PN0, PN1, ALN, HASN); \
        } else { \
            if (actC && !(var_ & 2)) { ATT_PV1(j, 0); ATT_PV1(j, 1); ATT_PV1(j, 2); ATT_PV1(j, 3); } \
            if (actN && !(var_ & 1)) ATT_PARTIAL(PN0, PN1, ALN, (j) + 1); \
        } \
        if (actN && !(var_ & 1)) ATT_RESC(ALN); \
        if (!(var_ & 8)) { if ((j) + 2 < NT) { if ((j) + NS - 1 < NT) ATT_VMWAIT((NS - 3) * IPT); else ATT_VMWAIT(0); } } \
    } while (0)
#if ATT_SIMPLE2
    if constexpr (ATT_EXCL && DQK == 64 && MODE == 0) {
    const bool trail = wid >= 4;
    __syncthreads();
#pragma unroll
    for (int t = 0; t < 3; ++t) if (t < NT) ATT_ISSUE(t);
    if (NT >= 3) ATT_VMWAIT(2 * IPT); else ATT_VMWAIT(0);
    f32x16 negm, pA0, pA1, pB0, pB1; bf16x8 pa0, pa1, pa2, pa3; float psC = 0.f, psN = 0.f;
#pragma unroll
    for (int r = 0; r < 16; ++r) negm[r] = 0.f;
    float lim_ = 16384.f; asm volatile("" : "+s"(lim_));
    ATT_BAR();
#define EX_QK(P0, P1, T) do { const LAS unsigned char* Kb = ring + ((T) & 3) * SS + 16384; \
        _Pragma("unroll") for (int d0 = 0; d0 < NQ; ++d0) { const LAS unsigned char* kp = Kb + kb4[d0 % NKB] + (d0 / NKB) * (NKB * 32); \
            const bf16x8 k0 = *(const LAS bf16x8*)kp, k1 = *(const LAS bf16x8*)(kp + 32 * DQK * 2); \
            if (d0 == 0) { P0 = __builtin_amdgcn_mfma_f32_32x32x16_bf16(k0, qr[0], negm, 0, 0, 0); P1 = __builtin_amdgcn_mfma_f32_32x32x16_bf16(k1, qr[0], negm, 0, 0, 0); } \
            else { P0 = __builtin_amdgcn_mfma_f32_32x32x16_bf16(k0, qr[d0], P0, 0, 0, 0); P1 = __builtin_amdgcn_mfma_f32_32x32x16_bf16(k1, qr[d0], P1, 0, 0, 0); } } } while (0)
#define EX_PKD(P, BASE, OUT) do { u32x4 w = {cvtpk(P[BASE + 0], P[BASE + 1]), cvtpk(P[BASE + 2], P[BASE + 3]), cvtpk(P[BASE + 4], P[BASE + 5]), cvtpk(P[BASE + 6], P[BASE + 7])}; OUT = *reinterpret_cast<bf16x8*>(&w); } while (0)
#define EX_SLOW(P0, P1, PS) do { if (__any(PS > lim_)) { const float d_ = PS > lim_ ? __builtin_amdgcn_logf(PS) : 0.f; const float al = __builtin_amdgcn_exp2f(-d_); \
        m_reg += d_; PS *= al; l_reg *= al; \
        _Pragma("unroll") for (int r = 0; r < 16; ++r) { P0[r] *= al; P1[r] *= al; negm[r] -= d_; } \
        if (hi == 0) al_l[r32] = al; LDS_WAIT(); \
        _Pragma("unroll") for (int r = 0; r < 16; ++r) { const float a_ = al_l[crow(r, hi)]; _Pragma("unroll") for (int d = 0; d < 4; ++d) o[d][r] *= a_; } } } while (0)
    {
        EX_QK(pA0, pA1, 0);
        float pmax = fmaxf(pA0[0], pA1[0]);
#pragma unroll
        for (int r = 1; r < 16; ++r) pmax = fmaxf(fmaxf(pmax, pA0[r]), pA1[r]);
        { auto rr = __builtin_amdgcn_permlane32_swap(__float_as_uint(pmax), __float_as_uint(pmax), false, false); pmax = fmaxf(__uint_as_float(rr[0]), __uint_as_float(rr[1])); }
        m_reg = pmax;
#pragma unroll
        for (int r = 0; r < 16; ++r) { negm[r] = -pmax; pA0[r] = __builtin_amdgcn_exp2f(pA0[r] - pmax); pA1[r] = __builtin_amdgcn_exp2f(pA1[r] - pmax); psC += pA0[r] + pA1[r]; }
        { auto rr = __builtin_amdgcn_permlane32_swap(__float_as_uint(psC), __float_as_uint(psC), false, false); psC = __uint_as_float(rr[0]) + __uint_as_float(rr[1]); }
    }
    if (NT >= 2) { if (NT >= 3) ATT_VMWAIT(IPT); else ATT_VMWAIT(0); }
    if (trail) ATT_BAR();
#define EX_PIECE(P0, P1, k, HASN_) do { if (HASN_) { P0[k] = __builtin_amdgcn_exp2f(P0[k]); P1[k] = __builtin_amdgcn_exp2f(P1[k]); psN += P0[k] + P1[k]; } } while (0)
#define EX_STEP(PC0, PC1, PN0, PN1, s, HASN_) do { \
        ATT_BAR();                                       \
        if ((s) + 3 < NT) ATT_ISSUE((s) + 3); \
        SBAR(); \
        if (HASN_) EX_QK(PN0, PN1, (s) + 1); \
        l_reg += psC; EX_PKD(PC0, 0, pa0); EX_PKD(PC0, 8, pa1); EX_PKD(PC1, 0, pa2); EX_PKD(PC1, 8, pa3); \
        SBAR(); \
        { const unsigned vbu_ = (unsigned)(uintptr_t)(vb0 + ((s) & 3) * SS); s16x4 trl[3], trh[3]; psN = 0.f; \
          ATT_TRR(0); ATT_TRR(1); \
          ATT_CHUNK(0, 4, EX_PIECE(PN0, PN1, 0, HASN_)); ATT_CHUNK(1, 4, EX_PIECE(PN0, PN1, 1, HASN_)); ATT_CHUNK(2, 4, EX_PIECE(PN0, PN1, 2, HASN_)); ATT_CHUNK(3, 4, EX_PIECE(PN0, PN1, 3, HASN_)); \
          ATT_CHUNK(4, 4, EX_PIECE(PN0, PN1, 4, HASN_)); ATT_CHUNK(5, 4, EX_PIECE(PN0, PN1, 5, HASN_)); ATT_CHUNK(6, 4, EX_PIECE(PN0, PN1, 6, HASN_)); ATT_CHUNK(7, 4, EX_PIECE(PN0, PN1, 7, HASN_)); \
          ATT_CHUNK(8, 4, EX_PIECE(PN0, PN1, 8, HASN_)); ATT_CHUNK(9, 4, EX_PIECE(PN0, PN1, 9, HASN_)); ATT_CHUNK(10, 4, EX_PIECE(PN0, PN1, 10, HASN_)); ATT_CHUNK(11, 4, EX_PIECE(PN0, PN1, 11, HASN_)); \
          ATT_CHUNK(12, 4, EX_PIECE(PN0, PN1, 12, HASN_)); ATT_CHUNK(13, 4, EX_PIECE(PN0, PN1, 13, HASN_)); ATT_CHUNK(14, 2, EX_PIECE(PN0, PN1, 14, HASN_)); ATT_CHUNK(15, 0, EX_PIECE(PN0, PN1, 15, HASN_)); } \
        if (HASN_) { { auto rr = __builtin_amdgcn_permlane32_swap(__float_as_uint(psN), __float_as_uint(psN), false, false); psN = __uint_as_float(rr[0]) + __uint_as_float(rr[1]); } \
            EX_SLOW(PN0, PN1, psN); psC = psN; } \
        if ((s) + 2 < NT) { if ((s) + 3 < NT) ATT_VMWAIT(IPT); else ATT_VMWAIT(0); } \
        ATT_BAR();                                       \
    } while (0)
    int s = 0;
#pragma unroll 1
    for (; s + 1 < NT; s += 2) { EX_STEP(pA0, pA1, pB0, pB1, s, true); EX_STEP(pB0, pB1, pA0, pA1, s + 1, ((s) + 2 < NT)); }
    if (s < NT) { EX_STEP(pA0, pA1, pB0, pB1, s, false); }
    if (!trail) ATT_BAR();
#undef EX_QK
#undef EX_PKD
#undef EX_SLOW
#undef EX_PIECE
#undef EX_STEP
    } else {
    __syncthreads();
#pragma unroll
    for (int t = 0; t < NS - 1; ++t) if (t < NT) ATT_ISSUE(t);
    if (NT >= NS - 1) ATT_VMWAIT((NS - 2) * IPT); else ATT_VMWAIT(0);
    f32x16 negm; bf16x8 pa0, pa1, pa2, pa3;
#pragma unroll
    for (int r = 0; r < 16; ++r) negm[r] = 0.f;
    float lim_ = 16384.f; asm volatile("" : "+s"(lim_));
    for (int j = 0; j < NT; ++j) {
        ATT_BAR();
        if (j + NS - 1 < NT) ATT_ISSUE(j + NS - 1);
        bool act_ = true;
        if (MODE == 1 && j >= 4) { const int kr = na_krlo + j - 4; act_ = (kr >= na_r0) && (kr < na_r0 + 8); }
        if (act_) {
        f32x16 p0, p1;
        {
            constexpr int KD = 2;
            const unsigned kbu = (unsigned)(uintptr_t)(ring + (j % NS) * SS + 16384);
            bf16x8 kf[KD + 1][2];
#define ATT_KRD(D_) do { const unsigned ka_ = kbu + (unsigned)(kb4[(D_) % NKB] + ((D_) / NKB) * (NKB * 32)); kf[(D_) % (KD + 1)][0] = k_read_asm<0>(ka_); kf[(D_) % (KD + 1)][1] = k_read_asm<32 * DQK * 2>(ka_); } while (0)
#pragma unroll
            for (int d0 = 0; d0 < KD; ++d0) if (d0 < NQ) ATT_KRD(d0);
#pragma unroll
            for (int d0 = 0; d0 < NQ; ++d0) {
                if (d0 + KD < NQ) ATT_KRD(d0 + KD);
                const int after = (NQ - 1 - d0) < KD ? (NQ - 1 - d0) : KD;
                if (after >= 2) asm volatile("s_waitcnt lgkmcnt(4)" ::: "memory"); else if (after == 1) asm volatile("s_waitcnt lgkmcnt(2)" ::: "memory"); else asm volatile("s_waitcnt lgkmcnt(0)" ::: "memory");
                SBAR();
                const bf16x8 k0 = kf[d0 % (KD + 1)][0], k1 = kf[d0 % (KD + 1)][1];
                if (d0 == 0) { p0 = __builtin_amdgcn_mfma_f32_32x32x16_bf16(k0, qr[0], negm, 0, 0, 0); p1 = __builtin_amdgcn_mfma_f32_32x32x16_bf16(k1, qr[0], negm, 0, 0, 0); }
                else { p0 = __builtin_amdgcn_mfma_f32_32x32x16_bf16(k0, qr[d0], p0, 0, 0, 0); p1 = __builtin_amdgcn_mfma_f32_32x32x16_bf16(k1, qr[d0], p1, 0, 0, 0); }
                SBAR(); }
#undef ATT_KRD
        }
        if (MODE == 1 && j >= 4) { const int kr = na_krlo + j - 4; const int cs_eff = na_cs;
            const LAS float* bt = (const LAS float*)(lds + LDS_BIAS) + 64 + (kr - na_r + 7) * 32 + (15 - na_c) + 4 * hi;
            float bb0[16], bb1[16];
#pragma unroll
            for (int r = 0; r < 16; ++r) { const int kc0 = (r & 3) + 8 * (r >> 2); bb0[r] = bt[kc0]; bb1[r] = bt[kc0 + 32]; }
            asm volatile("s_waitcnt lgkmcnt(0)" ::: "memory"); SBAR();
#pragma unroll
            for (int r = 0; r < 16; ++r) { const int kc0 = (r & 3) + 8 * (r >> 2);
                const int k0c = kc0 + 4 * hi - cs_eff, k1c = k0c + 32;
                p0[r] = ((unsigned)k0c < 16u) ? p0[r] + bb0[r] : NEGBIG; p1[r] = ((unsigned)k1c < 16u) ? p1[r] + bb1[r] : NEGBIG; } }
        if (j == 0) {
            float pmax = fmaxf(p0[0], p1[0]);
#pragma unroll
            for (int r = 1; r < 16; ++r) pmax = fmaxf(fmaxf(pmax, p0[r]), p1[r]);
            { auto rr = __builtin_amdgcn_permlane32_swap(__float_as_uint(pmax), __float_as_uint(pmax), false, false); pmax = fmaxf(__uint_as_float(rr[0]), __uint_as_float(rr[1])); }
            m_reg = pmax;
#pragma unroll
            for (int r = 0; r < 16; ++r) { p0[r] -= pmax; p1[r] -= pmax; negm[r] = -pmax; }
        }
        float ps = 0.f;
#pragma unroll
        for (int r = 0; r < 16; ++r) { p0[r] = __builtin_amdgcn_exp2f(p0[r]); p1[r] = __builtin_amdgcn_exp2f(p1[r]); ps += p0[r] + p1[r]; }
        { auto rr = __builtin_amdgcn_permlane32_swap(__float_as_uint(ps), __float_as_uint(ps), false, false); ps = __uint_as_float(rr[0]) + __uint_as_float(rr[1]); }
        if (__any(ps > lim_)) {
            const float d_ = ps > lim_ ? __builtin_amdgcn_logf(ps) : 0.f;
            const float al = __builtin_amdgcn_exp2f(-d_);
            m_reg += d_; ps *= al; l_reg *= al;
#pragma unroll
            for (int r = 0; r < 16; ++r) { p0[r] *= al; p1[r] *= al; negm[r] -= d_; }
            if (hi == 0) al_l[r32] = al; LDS_WAIT();
#pragma unroll
            for (int r = 0; r < 16; ++r) { const float a_ = al_l[crow(r, hi)];
#pragma unroll
                for (int d = 0; d < 4; ++d) o[d][r] *= a_; }
        }
        l_reg += ps;
#define ATT_PKD(P, BASE, OUT) do { u32x4 w = {cvtpk(P[BASE + 0], P[BASE + 1]), cvtpk(P[BASE + 2], P[BASE + 3]), cvtpk(P[BASE + 4], P[BASE + 5]), cvtpk(P[BASE + 6], P[BASE + 7])}; OUT = *reinterpret_cast<bf16x8*>(&w); } while (0)
        ATT_PKD(p0, 0, pa0); ATT_PKD(p0, 8, pa1); ATT_PKD(p1, 0, pa2); ATT_PKD(p1, 8, pa3);
#undef ATT_PKD
        {
            const unsigned vu = (unsigned)(uintptr_t)(vb0 + (j % NS) * SS);
            s16x4 fl[2][4], fh[2][4];
#define ATT_VRD(B, S_) do { fl[S_][0] = tr_read_asm<v_rd_off(B, 0, 0)>(vu); fh[S_][0] = tr_read_asm<v_rd_off(B, 0, 1)>(vu); fl[S_][1] = tr_read_asm<v_rd_off(B, 1, 0)>(vu); fh[S_][1] = tr_read_asm<v_rd_off(B, 1, 1)>(vu); \
                fl[S_][2] = tr_read_asm<v_rd_off(B, 2, 0)>(vu); fh[S_][2] = tr_read_asm<v_rd_off(B, 2, 1)>(vu); fl[S_][3] = tr_read_asm<v_rd_off(B, 3, 0)>(vu); fh[S_][3] = tr_read_asm<v_rd_off(B, 3, 1)>(vu); } while (0)
#define ATT_VMM(B, S_) do { \
                o[B] = __builtin_amdgcn_mfma_f32_32x32x16_bf16(pa0, (bf16x8){fl[S_][0][0], fl[S_][0][1], fl[S_][0][2], fl[S_][0][3], fh[S_][0][0], fh[S_][0][1], fh[S_][0][2], fh[S_][0][3]}, o[B], 0, 0, 0); \
                o[B] = __builtin_amdgcn_mfma_f32_32x32x16_bf16(pa1, (bf16x8){fl[S_][1][0], fl[S_][1][1], fl[S_][1][2], fl[S_][1][3], fh[S_][1][0], fh[S_][1][1], fh[S_][1][2], fh[S_][1][3]}, o[B], 0, 0, 0); \
                o[B] = __builtin_amdgcn_mfma_f32_32x32x16_bf16(pa2, (bf16x8){fl[S_][2][0], fl[S_][2][1], fl[S_][2][2], fl[S_][2][3], fh[S_][2][0], fh[S_][2][1], fh[S_][2][2], fh[S_][2][3]}, o[B], 0, 0, 0); \
                o[B] = __builtin_amdgcn_mfma_f32_32x32x16_bf16(pa3, (bf16x8){fl[S_][3][0], fl[S_][3][1], fl[S_][3][2], fl[S_][3][3], fh[S_][3][0], fh[S_][3][1], fh[S_][3][2], fh[S_][3][3]}, o[B], 0, 0, 0); } while (0)
            ATT_VRD(0, 0);
            ATT_VRD(1, 1); asm volatile("s_waitcnt lgkmcnt(8)" ::: "memory"); SBAR(); ATT_VMM(0, 0); SBAR();
            ATT_VRD(2, 0); asm volatile("s_waitcnt lgkmcnt(8)" ::: "memory"); SBAR(); ATT_VMM(1, 1); SBAR();
            ATT_VRD(3, 1); asm volatile("s_waitcnt lgkmcnt(8)" ::: "memory"); SBAR(); ATT_VMM(2, 0); SBAR();
            asm volatile("s_waitcnt lgkmcnt(0)" ::: "memory"); SBAR(); ATT_VMM(3, 1); SBAR();
#undef ATT_VRD
#undef ATT_VMM
        }
        }
        if (j + 1 < NT) { if (j + NS - 1 < NT) ATT_VMWAIT((NS - 2) * IPT); else ATT_VMWAIT(0); }
    }
    }
    (void)C; (void)var_;
#elif ATT_SKEW1
    constexpr bool EXP_EARLY = true;
    const bool trail = wid >= 4;
    __syncthreads();
#pragma unroll
    for (int t = 0; t < NS - 2; ++t) if (t < NT) ATT_ISSUE(t);
    f32x16 p0, p1; float al = 1.f, pmax_ = 0.f; bf16x8 pa0, pa1, pa2, pa3;
    if (NS == 3) ATT_VMWAIT(0); else { if (NT >= 2) ATT_VMWAIT(IPT); else ATT_VMWAIT(0); }
#define ATT_STAGE_A(t) do { __builtin_amdgcn_s_setprio(1); ATT_QKT(p0, p1, t); __builtin_amdgcn_s_setprio(0); ATT_PART_A(p0, p1, t); ATT_PART_B(p0, p1, al, t); ATT_PART_C(p0, p1, t); ATT_FINISH(p0, p1, al); ATT_RESC(al); } while (0)
#define ATT_STAGE_B(t) do { __builtin_amdgcn_s_setprio(1); ATT_PV1(t, 0); ATT_PV1(t, 1); ATT_PV1(t, 2); ATT_PV1(t, 3); __builtin_amdgcn_s_setprio(0); } while (0)
    for (int k = 0; k <= NT; ++k) {
        ATT_BAR();
        if (k + NS - 2 < NT) ATT_ISSUE(k + NS - 2);
        if (!trail) { if (k < NT) { ATT_STAGE_A(k); SBAR(); ATT_STAGE_B(k); } }
        else { if (k >= 1) ATT_STAGE_B(k - 1); SBAR(); if (k < NT) ATT_STAGE_A(k); }
        if (k + 1 < NT) { if (NS > 3 && k + NS - 2 < NT) ATT_VMWAIT((NS - 3) * IPT); else ATT_VMWAIT(0); }
    }
#undef ATT_STAGE_A
#undef ATT_STAGE_B
#else
    constexpr bool EXP_EARLY = (DQK == 64) && !ATT_PROBE_SIMPLE;
    __syncthreads();
#pragma unroll
    for (int t = 0; t < NS - 1; ++t) if (t < NT) ATT_ISSUE(t);
    if (NT >= NS - 1) ATT_VMWAIT((NS - 2) * IPT); else ATT_VMWAIT(0);
    ATT_BAR();
    f32x16 pA0, pA1, pB0, pB1; float alA = 1.f, alB = 1.f, pmax_ = 0.f; bf16x8 pa0, pa1, pa2, pa3;
    ATT_QKT(pA0, pA1, 0); ATT_PARTIAL(pA0, pA1, alA, 0); ATT_RESC(alA);
    if (NT >= 2) { if (NT >= NS - 1) ATT_VMWAIT((NS - 3) * IPT); else ATT_VMWAIT(0); }
    int j = 0;
    if (DQK == 64 && !ATT_PROBE_SIMPLE) {
        for (; j + 2 < NT; j += 2) {
            ATT_STEP(pA0, pA1, alA, pB0, pB1, alB, j, true);
            ATT_STEP(pB0, pB1, alB, pA0, pA1, alA, j + 1, true);
        }
        if (j + 1 < NT) { ATT_STEP(pA0, pA1, alA, pB0, pB1, alB, j, true); ATT_STEP(pB0, pB1, alB, pA0, pA1, alA, j + 1, false); }
        else { ATT_STEP(pA0, pA1, alA, pB0, pB1, alB, j, false); }
    } else {
        for (; j + 1 < NT; j += 2) {
            ATT_STEP(pA0, pA1, alA, pB0, pB1, alB, j, ((j) + 1 < NT));
            ATT_STEP(pB0, pB1, alB, pA0, pA1, alA, j + 1, ((j) + 2 < NT));
        }
        if (j < NT) ATT_STEP(pA0, pA1, alA, pB0, pB1, alB, j, false);
    }
#endif
#undef ATT_BAR
#undef ATT_SG
#undef ATT_ACTIVE
#undef ATT_QKT
#undef ATT_PARTIAL
#undef ATT_PART_A
#undef ATT_PART_B
#undef ATT_PART_C
#undef ATT_PK4
#undef ATT_FINISH
#undef ATT_RESC
#undef ATT_PV1
#undef ATT_PVX
#undef ATT_CHUNK
#undef ATT_EXPR
#undef ATT_MAX2
#undef ATT_MM
#undef ATT_TRR
#undef ATT_STEP
#undef ATT_ROW0
#undef ATT_ISSUE
#undef ATT_VMWAIT
}
__device__ __forceinline__ void row_recip(float l_reg, LAS unsigned char* lds, float (&rli)[16], const int wid) {
    const int lane = lane_opq(), r32 = lane & 31, hi = lane >> 5;
    LAS float* wsf = (LAS float*)(lds + LDS_WS) + wid * 64;
    if (hi == 0) wsf[r32] = l_reg; LDS_WAIT();
#pragma unroll
    for (int r = 0; r < 16; ++r) rli[r] = __builtin_amdgcn_rcpf(wsf[crow(r, hi)]);
    LDS_WAIT();
}
__device__ __forceinline__ void store_o(const f32x16 (&o)[4], const float (&rli)[16], bf16_t* Ow, int ldo) {
    const int lane = lane_opq(), r32 = lane & 31, hi = lane >> 5;
#pragma unroll
    for (int r = 0; r < 16; ++r) { GAS bf16_t* p = (GAS bf16_t*)Ow + (size_t)(4 * hi) * ldo + r32; asm volatile("" : "+v"(p)); p += (size_t)crow(r, 0) * ldo;
#pragma unroll
        for (int d0 = 0; d0 < 4; ++d0) p[d0 * 32] = (bf16_t)(cvtpk(o[d0][r] * rli[r], 0.f) & 0xffffu); }
}
}
struct Args { const float* in[27]; float* out; unsigned char* ws; int ph_lo, ph_hi; int var, pad; };
enum { I_X = 0, I_C, I_CTX, I_CCTX, I_ADA_W1, I_ADA_W2, I_ADA_B, I_LN_G, I_LN_B, I_MLP_W1, I_MLP_W2, I_DA_WQKV, I_DA_WO, I_DA_LQ1, I_DA_LK1, I_DA_LQ2, I_DA_LK2, I_DA_SUBG,
       I_MLA_WDOWN, I_MLA_QG, I_MLA_WUQ, I_MLA_KVG, I_MLA_WUKV, I_MLA_WO, I_NA_WQKV, I_NA_WO, I_NA_RPB };

static_assert(sizeof(Args) == 248, "Args layout");
namespace cvs {
constexpr int NMAT = 18;
__host__ __device__ constexpr int count(int m) {
    return (m == 4) ? 64 * 33 : (m == 5) ? 24 * 192 : (m == 6) ? 8 * 256 : (m == 7) ? 128 * 64
         : ((m < 4 ? m : (m < 10 ? m - 6 : (m < 14 ? m - 10 : m - 14))) == 0) ? 64 * 192 : ((m < 4 ? m : (m < 10 ? m - 6 : (m < 14 ? m - 10 : m - 14))) == 1) ? 64 * 64 : 64 * 256; }
__host__ __device__ constexpr int start(int m) { int s = 0; for (int i = 0; i < m; ++i) s += count(i); return s; }
constexpr int TOTAL = start(NMAT);
static_assert(TOTAL == 197184 && count(8) == 16384 && count(9) == 16384 && count(0) == 12288 && count(1) == 4096, "stream");
#ifndef CVT_PER_CU
#define CVT_PER_CU 130
#endif
#ifndef CVT_IN_ATT
#define CVT_IN_ATT 0
#endif
constexpr int NWIN = 8;
__host__ __device__ constexpr int win_phase(int w) { using namespace cfg; return w == 0 ? PH_L0 + 0 : w == 1 ? PH_L0 + 6 : w == 2 ? PH_L0 + 10 + 0 : w == 3 ? PH_L0 + 10 + 2 : w == 4 ? PH_L0 + 10 + 6 : w == 5 ? PH_L0 + 20 + 0 : w == 6 ? PH_L0 + 20 + 6 : PH_L0 + 30 + 0; }
__host__ __device__ constexpr int win_cap(int w) { return CVT_IN_ATT ? 0 : w == 0 ? 160 * CVT_PER_CU : w == 1 ? 128 * (CVT_PER_CU * 165 / 130) : w == 2 ? 206 * (CVT_PER_CU * 100 / 130) : w == 3 ? 160 * (CVT_PER_CU * 45 / 130) : w == 4 ? 128 * (CVT_PER_CU * 165 / 130) : w == 5 ? 160 * CVT_PER_CU : w == 6 ? 128 * (CVT_PER_CU * 165 / 130) : 160 * CVT_PER_CU; }
__host__ __device__ constexpr int cap_before(int phase) { int s = 0; for (int w = 0; w < NWIN; ++w) if (win_phase(w) < phase) s += win_cap(w); return s; }
__host__ __device__ constexpr int use_phase(int m) { using namespace cfg;
    const int l = m < 4 ? 0 : (m < 10 ? 1 : (m < 14 ? 2 : 3)), j = m < 4 ? m : (m < 10 ? m - 4 : (m < 14 ? m - 10 : m - 14));
    return PH_L0 + 10 * l + (l == 1 ? (j == 0 ? 0 : j <= 2 ? 2 : j == 3 ? 4 : j == 4 ? 6 : 7) : (j == 0 ? 0 : j == 1 ? 4 : j == 2 ? 6 : 7)); }
__host__ __device__ constexpr int prefix() { int S = 0; for (int m = 0; m < NMAT; ++m) { const int need = start(m) + count(m) - cap_before(use_phase(m)); if (need > S) S = need; } return S; }
constexpr int CVT_S = CVT_IN_ATT ? count(0) : prefix();
__host__ __device__ constexpr int win_lo(int w) { int s = CVT_S; for (int i = 0; i < w; ++i) s += win_cap(i); return s < TOTAL ? s : TOTAL; }
__host__ __device__ constexpr int win_hi(int w) { const int s = win_lo(w) + win_cap(w); return s < TOTAL ? s : TOTAL; }
}
__global__ void __launch_bounds__(512, 2) fwd(Args a) {
    using namespace cfg;
    extern __shared__ __attribute__((aligned(16))) unsigned char lds_raw[];
    LAS unsigned char* lds = (LAS unsigned char*)lds_raw;
    LAS unsigned char* ring = lds + RING_OFF;
    const int tid0 = threadIdx.x;
    const int wave_id = __builtin_amdgcn_readfirstlane(tid0 >> 6);
    for (int u = tid0; u < LDSCTL_BYTES / 4; u += 512) ((LAS unsigned*)lds)[u] = 0u;
    __syncthreads();
    const int lo = a.ph_lo, hi = a.ph_hi;
#ifdef PROBE_VAR
    const int avar = a.var;
#else
    constexpr int avar = 0;
#endif
    if (hi - lo > 1) (void)xcd_barrier_post((unsigned*)(ARG_WS() + WS_CTL) + 4096, (volatile LAS unsigned*)lds, tid0 == 0);
#define IN(k) (lo <= (k) && (k) < hi)
#define PHASE_IDS() int tid = wave_id * 64 + lane_id_opq(); asm volatile("" : "+v"(tid)); int G = gridDim.x, bx = blockIdx.x; asm volatile("" : "+s"(G), "+s"(bx)); \
    const int vcu = (G % 8 == 0) ? (bx % 8) * (G / 8) + bx / 8 : bx;   \
    int wave = wave_id; asm volatile("" : "+s"(wave)); const int NGW = G * 8, lane = tid & 63, gw = vcu * 8 + wave; (void)lane; (void)gw; (void)NGW
#define CVT_STREAM(lo_, hi_, r_, nr_) do { LAS float* scr_ = (LAS float*)(ring + wave * 16640); int st_ = 0; \
        _Pragma("unroll 1") for (int m_ = 0; m_ < cvs::NMAT; ++m_) { const int cn_ = cvs::count(m_); const int a_ = (lo_) > st_ ? (lo_) - st_ : 0, b_ = ((hi_) - st_) < cn_ ? (hi_) - st_ : cn_; \
            if (a_ < b_) { const int l_ = m_ < 4 ? 0 : (m_ < 10 ? 1 : (m_ < 14 ? 2 : 3)), j_ = m_ < 4 ? m_ : (m_ < 10 ? m_ - 4 : (m_ < 14 ? m_ - 10 : m_ - 14)); \
                const float* W_; bf16_t* T_; int K_, N_; \
                if (l_ == 1) { \
                    if (j_ == 0) { W_ = INP(I_MLA_WDOWN); T_ = (bf16_t*)(ARG_WS() + WS_WDOWN); K_ = 4096; N_ = MLA_DOWN; } \
                    else if (j_ == 1) { W_ = INP(I_MLA_WUQ); T_ = (bf16_t*)(ARG_WS() + WS_WUQ); K_ = 1536; N_ = 12288; } \
                    else if (j_ == 2) { W_ = INP(I_MLA_WUKV); T_ = (bf16_t*)(ARG_WS() + WS_WUKV); K_ = 512; N_ = 16384; } \
                    else if (j_ == 3) { W_ = INP(I_MLA_WO); T_ = (bf16_t*)(ARG_WS() + WS_WOMLA); K_ = 8192; N_ = 4096; } \
                    else if (j_ == 4) { W_ = INP(I_MLP_W1) + (size_t)1 * 4096 * 16384; T_ = (bf16_t*)(ARG_WS() + WS_W1 + 1 * SZ_W1); K_ = 4096; N_ = 16384; } \
                    else { W_ = INP(I_MLP_W2) + (size_t)1 * 4096 * 16384; T_ = (bf16_t*)(ARG_WS() + WS_W2 + 1 * SZ_W1); K_ = 16384; N_ = 4096; } \
                } else { const int sl_ = l_ == 3 ? 1 : 0; \
                    if (j_ == 0) { W_ = l_ == 2 ? INP(I_NA_WQKV) : INP(I_DA_WQKV) + (size_t)sl_ * 4096 * 12288; T_ = l_ == 2 ? (bf16_t*)(ARG_WS() + WS_WQKV_NA) : (bf16_t*)(ARG_WS() + WS_WQKV_DA + sl_ * SZ_WQKV); K_ = 4096; N_ = 12288; } \
                    else if (j_ == 1) { W_ = l_ == 2 ? INP(I_NA_WO) : INP(I_DA_WO) + (size_t)sl_ * 4096 * 4096; T_ = l_ == 2 ? (bf16_t*)(ARG_WS() + WS_WO_NA) : (bf16_t*)(ARG_WS() + WS_WO_DA + sl_ * SZ_WO); K_ = 4096; N_ = 4096; } \
                    else if (j_ == 2) { W_ = INP(I_MLP_W1) + (size_t)l_ * 4096 * 16384; T_ = (bf16_t*)(ARG_WS() + WS_W1 + l_ * SZ_W1); K_ = 4096; N_ = 16384; } \
                    else { W_ = INP(I_MLP_W2) + (size_t)l_ * 4096 * 16384; T_ = (bf16_t*)(ARG_WS() + WS_W2 + l_ * SZ_W1); K_ = 16384; N_ = 4096; } } \
                cvt_matrix(W_, K_, N_, T_, scr_, (r_), (nr_), lane, a_, b_); } \
            st_ += cn_; } } while (0)
#define CVT_WINDOW(lo_, hi_, rem_) do { const int wl_ = (lo_), wh_ = (hi_); if (bx >= (rem_) && wl_ < wh_) { CVT_STREAM(wl_, wh_, (bx - (rem_)) * 8 + wave, (G - (rem_)) * 8); } } while (0)
#define SEAM(k) do { if (IN(k) && IN((k) + 1)) { XcdBarrier bar_; bar_.bar = (unsigned*)(ARG_WS() + WS_CTL) + 4096; bar_.x = xb_xcc_id(); bar_.st = (volatile LAS unsigned*)lds; xcd_barrier(bar_, wave_id == 0 && lane_id_opq() == 0); } } while (0)
#define tab ((float*)(ARG_WS() + WS_TAB))
#define tpart ((float*)(ARG_WS() + WS_TPART))
#define MOD ((float*)(ARG_WS() + WS_MOD))
#define X ((h16_t*)(ARG_WS() + WS_X))
#define H ((bf16_t*)(ARG_WS() + WS_H))
#define QKV ((bf16_t*)(ARG_WS() + WS_QKV))
#define BIG ((bf16_t*)(ARG_WS() + WS_BIG))
#define DOWN ((float*)(ARG_WS() + WS_DOWN))
#define CQ ((bf16_t*)(ARG_WS() + WS_CQ))
#define CKV ((bf16_t*)(ARG_WS() + WS_CKV))
#define KR ((bf16_t*)(ARG_WS() + WS_KR))
#define OB ((bf16_t*)(ARG_WS() + WS_O))

#ifndef SKIP_CVT
    if (IN(PH_CVT)) {
        PHASE_IDS();
#ifdef PROBE_CVT2
#pragma unroll 1
        for (int rep_ = 0; rep_ < 2; ++rep_) {
#endif
        LAS float* scr = (LAS float*)(ring + wave * 16640);
        CVT_STREAM(0, cvs::CVT_S, gw, NGW);
#ifdef PROBE_CVT2
        }
#endif
        { u32x4* z = (u32x4*)(ARG_WS() + WS_WDOWN + (size_t)MLA_DOWN * 4096 * 2); const int n16 = (MLA_DOWN_PAD - MLA_DOWN) * 4096 * 2 / 16;
          for (int i = gw * 64 + lane; i < n16; i += NGW * 64) z[i] = (u32x4){0u, 0u, 0u, 0u}; }
        if (bx == 0) for (int t = tid; t < 1024; t += 512) { const int pos = t >> 4, j = t & 15;
            const float inv = __builtin_amdgcn_exp2f(-(float)j * (13.287712379549449f / 16.f)); const float ang = (float)pos * inv;
            tab[t] = __cosf(ang); tab[1024 + t] = __sinf(ang); }
        __syncthreads();
        for (int u = vcu; u < 256; u += G) {
            const int l = u >> 6, jc = (u >> 3) & 7, ksl = u & 7;
            const float* w1 = INP(I_ADA_W1) + (size_t)l * 4096 * 512 + jc * 64 + lane;
            const int kbase = ksl * 512 + wave * 64;
            float s0 = 0.f, s1 = 0.f, s2 = 0.f;
#pragma unroll 1
            for (int k0 = 0; k0 < 64; k0 += 32) { float w[32];
#pragma unroll
                for (int kk = 0; kk < 32; ++kk) w[kk] = NTL(&w1[(size_t)(kbase + k0 + kk) * 512]);
#pragma unroll
                for (int kk = 0; kk < 32; ++kk) { const int k = kbase + k0 + kk; s0 += silu_f(INP(I_C)[k]) * w[kk]; s1 += silu_f(INP(I_C)[4096 + k]) * w[kk]; s2 += silu_f(INP(I_CCTX)[k]) * w[kk]; } }
            LAS float* red = (LAS float*)ring;
            red[(wave * 3 + 0) * 64 + lane] = s0; red[(wave * 3 + 1) * 64 + lane] = s1; red[(wave * 3 + 2) * 64 + lane] = s2;
            __syncthreads();
            if (tid < 192) { const int c = tid >> 6, j = tid & 63; float s = 0.f;
#pragma unroll
                for (int w = 0; w < 8; ++w) s += red[(w * 3 + c) * 64 + j];
                tpart[((l * 8 + ksl) * 3 + c) * 512 + jc * 64 + j] = s; }
            __syncthreads();
        }
    }
#endif
    SEAM(PH_CVT);
    if (IN(PH_MOD)) {
        PHASE_IDS();
        LAS float* tl = (LAS float*)ring;
        for (int u = vcu; u < 4 * 48; u += G) {
            const int l = u / 48, n = (u % 48) * 512 + tid;
            __syncthreads();
            for (int e = tid; e < 1536; e += 512) { const int c = e >> 9, j = e & 511; float s = 0.f;
#pragma unroll
                for (int ks = 0; ks < 8; ++ks) s += tpart[((l * 8 + ks) * 3 + c) * 512 + j];
                tl[e] = s; }
            __syncthreads();
            const float* w2 = INP(I_ADA_W2) + (size_t)l * 512 * 24576 + n;
            float s0 = 0.f, s1 = 0.f, s2 = 0.f;
#pragma unroll 1
            for (int j0 = 0; j0 < 512; j0 += 32) {
                float w[32];
#pragma unroll
                for (int j = 0; j < 32; ++j) w[j] = NTL(&w2[(size_t)(j0 + j) * 24576]);
#pragma unroll
                for (int j = 0; j < 32; ++j) { s0 += tl[j0 + j] * w[j]; s1 += tl[512 + j0 + j] * w[j]; s2 += tl[1024 + j0 + j] * w[j]; } }
            const float bb = INP(I_ADA_B)[l * 24576 + n];
            MOD[(size_t)(l * 3 + 0) * 24576 + n] = s0 + bb; MOD[(size_t)(l * 3 + 1) * 24576 + n] = s1 + bb; MOD[(size_t)(l * 3 + 2) * 24576 + n] = s2 + bb;
        }
    }
    SEAM(PH_MOD);
    if (IN(PH_INIT)) {
        PHASE_IDS();
        for (int row = gw; row < MALL; row += NGW) {
            const float* src = row < MLAT ? INP(I_X) + (size_t)row * D : INP(I_CTX) + (size_t)(row - MLAT) * D;
            const int cond = row < SEQ ? 0 : (row < MLAT ? 1 : 2);
            const float* m = MOD + (size_t)(0 * 3 + cond) * 24576;
            init_row(src, X + (size_t)row * D, H + (size_t)row * D, m + 1 * 4096, m + 0 * 4096, lane);
        }
    }
    SEAM(PH_INIT);

#pragma unroll 1
    for (int sl = 0; sl < 2 * DEPTH; ++sl) {
        const int l = sl >> 1, sub = sl & 1;
        const int kind = l % 3, slot = l / 3, pb = PH_L0 + PH_PER_LAYER * l;
        const bool with_ctx = l < DEPTH - 1;
        const int Mrows = with_ctx ? MALL : MLAT;
        const float* modl = MOD + (size_t)l * 3 * 24576;
        const int o_ld = kind == 1 ? 8192 : 4096;
        if (sub == 0) {
#ifndef SKIP_G0
        if (IN(pb + 0)) {
            PHASE_IDS();
            if (kind == 1) {
                pg8::Gemm g{H, (const bf16_t*)(ARG_WS() + WS_WDOWN), MALL, MLA_DOWN_PAD, 4096, 4096, 4096}; pg8::StaticOrder S; S.init(MALL, MLA_DOWN_PAD, G, bx);
                pg8::EpiF32 E{DOWN, MLA_DOWN_PAD};
                pg8::gemm_phase<pg8::EpiF32, pg8::StaticOrder, true, true>(ring, g, S, E, wave_id);
                CVT_WINDOW(cvs::win_lo(2), cvs::win_hi(2), (34 * 9) % G);
            } else {
                const bf16_t* Wt = kind == 0 ? (const bf16_t*)(ARG_WS() + WS_WQKV_DA + slot * SZ_WQKV) : (const bf16_t*)(ARG_WS() + WS_WQKV_NA);
                pg8::Gemm g{H, Wt, MALL, 12288, 4096, 4096, 4096}; pg8::StaticOrder S; S.init(MALL, 12288, G, bx);
                pg8::EpiRope<0> E{QKV, 12288, tab, kind == 0 ? 8192 : 0, 4096, (kind == 0 ? 0.125f : 0.08838834764831845f) * LOG2E};
                pg8::gemm_phase<pg8::EpiRope<0>, pg8::StaticOrder, true, true>(ring, g, S, E, wave_id);
                CVT_WINDOW(l == 0 ? cvs::win_lo(0) : (l == 2 ? cvs::win_lo(5) : cvs::win_lo(7)), l == 0 ? cvs::win_hi(0) : (l == 2 ? cvs::win_hi(5) : cvs::win_hi(7)), (34 * 48) % G);
            }
        }
#endif
        SEAM(pb + 0);
        if (kind == 1) {
            if (IN(pb + 1)) {
        PHASE_IDS();
                for (int row = gw; row < MALL; row += NGW)
                    mla_norm_row(DOWN + (size_t)row * MLA_DOWN_PAD, CQ + (size_t)row * MLA_QR, CKV + (size_t)row * MLA_KVR, KR + (size_t)row * 64, INP(I_MLA_QG), INP(I_MLA_KVG), tab, row, lane);
            }
            SEAM(pb + 1);
#ifndef SKIP_G2
            if (IN(pb + 2)) {
            PHASE_IDS();
                { pg8::Gemm g{CQ, (const bf16_t*)(ARG_WS() + WS_WUQ), MALL, 12288, MLA_QR, MLA_QR, MLA_QR}; pg8::StaticOrder S; S.init(MALL, 12288, G, bx);
                  pg8::EpiRope<1> E{QKV, 12288, tab, 0, 12288, 0.07216878364870322f * LOG2E};
                  pg8::gemm_phase<pg8::EpiRope<1>, pg8::StaticOrder, true, true>(ring, g, S, E, wave_id); }
                CVT_WINDOW(cvs::win_lo(3), cvs::win_hi(3), (34 * 48) % G);
                __syncthreads();
                { pg8::Gemm g{CKV, (const bf16_t*)(ARG_WS() + WS_WUKV), MALL, 16384, MLA_KVR, MLA_KVR, MLA_KVR}; pg8::StaticOrder S; S.init(MALL, 16384, G, bx);
                  pg8::EpiBf16<0> E{BIG, 16384};
                  pg8::gemm_phase<pg8::EpiBf16<0>, pg8::StaticOrder, true, true>(ring, g, S, E, wave_id); }
            }
#endif
            SEAM(pb + 2);
        }
        if (IN(pb + 3)) {
        PHASE_IDS();
#ifdef PROBE_ATT2
#pragma unroll 1
        for (int rep_ = 0; rep_ < 2; ++rep_) {
#endif
            if (false) {}
#ifndef SKIP_DA
            else if (kind == 0) {
                const float lam_init = l == 0 ? 0.2f : 0.55605820f;
                const float d1 = wave_sum(INP(I_DA_LQ1)[slot * 64 + lane] * INP(I_DA_LK1)[slot * 64 + lane]);
                const float d2 = wave_sum(INP(I_DA_LQ2)[slot * 64 + lane] * INP(I_DA_LK2)[slot * 64 + lane]);
                const float lam = expf(d1) - expf(d2) + lam_init;
                const float Cs = 0.125f * LOG2E;
                const float* subg = INP(I_DA_SUBG) + slot * 128;
                const int NUL = 1024, NU = NUL + (with_ctx ? 64 : 0);
                int cvt_at = (CVT_IN_ATT && l == 0) ? vcu + (vcu & 3) * G : -1;
                for (int u = vcu; u < NU; u += G) {
                    if (u == cvt_at) { __syncthreads(); CVT_STREAM(cvs::CVT_S, cvs::TOTAL, gw, NGW); __syncthreads(); }
                    int b, h, row0, NT;
                    if (u < NUL) { const int qb = u & 15; h = (u >> 4) & 31; b = u >> 9; row0 = b * SEQ + qb * 256; NT = 68; }
                    else { const int v = u - NUL; h = v & 31; b = v >> 5; row0 = MLAT + b * CTX; NT = 4; }
                    f32x16 o[4]; float l_reg; float rli[16];
#pragma unroll 1
                    for (int c = 0; c < 2; ++c) {
                        att::Src S; S.Q = QKV + (size_t)row0 * 12288 + (2 * h + c) * 64; S.ldq = 12288; S.K1 = QKV + 4096 + (2 * h + c) * 64; S.ldk1 = 12288; S.K2 = nullptr; S.ldk2 = 0;
                        S.V = QKV + 8192 + h * 128; S.ldv = 12288; S.ctx_row0 = MLAT + b * CTX; S.lat_row0 = b * SEQ; S.NT = NT;
                        att::attn_core<64, 0>(S, Cs, ring, o, l_reg, wave_id, avar, 0, 0, 0);
                        att::row_recip(l_reg, ring, rli, wave_id);
                        if (c == 0) { float* stash = (float*)(ARG_WS() + WS_STASH) + (size_t)bx * 32768 + wave * 4096 + att::lane_opq();
#pragma unroll
                            for (int r = 0; r < 16; ++r) { GAS float* sp = (GAS float*)stash; asm volatile("" : "+v"(sp)); sp += r * 256;
#pragma unroll
                                for (int d0 = 0; d0 < 4; ++d0) sp[d0 * 64] = o[d0][r] * rli[r]; }
                        }
                    }
                    const int lane2 = att::lane_opq(), r32 = lane2 & 31, hi = lane2 >> 5; const float* stash = (const float*)(ARG_WS() + WS_STASH) + (size_t)bx * 32768 + wave * 4096 + lane2;
                    bf16_t* Ow = OB + (size_t)(row0 + wave * 32) * 4096 + h * 128;
                    float gsub[4];
#pragma unroll
                    for (int d0 = 0; d0 < 4; ++d0) gsub[d0] = subg[d0 * 32 + r32] * (1.f - lam_init);
                    float stv[16][4];
#pragma unroll
                    for (int w4 = 0; w4 < 4; ++w4) { const GAS float* sp = (const GAS float*)stash + w4 * 1024; asm volatile("" : "+v"(sp));
#pragma unroll
                        for (int e = 0; e < 16; ++e) stv[w4 * 4 + (e >> 2)][e & 3] = sp[e * 64]; }
#pragma unroll
                    for (int r = 0; r < 16; ++r) { float x[4]; float s = 0.f;
#pragma unroll
                        for (int d0 = 0; d0 < 4; ++d0) { x[d0] = stv[r][d0] - lam * (o[d0][r] * rli[r]); s += x[d0] * x[d0]; }
                        s += __shfl_xor(s, 1); s += __shfl_xor(s, 2); s += __shfl_xor(s, 4); s += __shfl_xor(s, 8); s += __shfl_xor(s, 16);
                        float eps_ = 1e-5f; asm volatile("" : "+s"(eps_)); const float rs = __builtin_amdgcn_rsqf(s * (1.f / 128.f) + eps_);
                        GAS bf16_t* p = (GAS bf16_t*)Ow + (size_t)(4 * hi) * 4096 + r32; asm volatile("" : "+v"(p)); p += (size_t)att::crow(r, 0) * 4096;
#pragma unroll
                        for (int d0 = 0; d0 < 4; ++d0) p[d0 * 32] = (bf16_t)(cvtpk(x[d0] * rs * gsub[d0], 0.f) & 0xffffu);
                        asm volatile("" ::: "memory"); }
                }
            }
#endif
#ifndef SKIP_MLA
            else if (kind == 1) {
                const float Cs = 0.07216878364870322f * LOG2E;
                const int NUL = 2048, NU = NUL + (with_ctx ? 128 : 0);
                for (int u = vcu; u < NU; u += G) {
                    int b, h, row0, NT;
                    if (u < NUL) { const int qb = u & 15; h = (u >> 4) & 63; b = u >> 10; row0 = b * SEQ + qb * 256; NT = 68; }
                    else { const int v = u - NUL; h = v & 63; b = v >> 6; row0 = MLAT + b * CTX; NT = 4; }
                    att::Src S; S.Q = QKV + (size_t)row0 * 12288 + h * 192; S.ldq = 12288; S.K1 = BIG + h * 256; S.ldk1 = 16384; S.K2 = KR; S.ldk2 = 64;
                    S.V = BIG + h * 256 + 128; S.ldv = 16384; S.ctx_row0 = MLAT + b * CTX; S.lat_row0 = b * SEQ; S.NT = NT;
                    f32x16 o[4]; float l_reg; float rli[16];
                    att::attn_core<192, 0>(S, Cs, ring, o, l_reg, wave_id, 0, 0, 0, 0);
                    att::row_recip(l_reg, ring, rli, wave_id);
                    att::store_o(o, rli, OB + (size_t)(row0 + wave * 32) * 8192 + h * 128, 8192);
                }
            }
#endif
#ifndef SKIP_NA
            else if (kind == 2) {
                const float Cs = 0.08838834764831845f * LOG2E;
                const int NUL = 1024, NU = NUL + (with_ctx ? 64 : 0);
                LAS float* btab = (LAS float*)(ring + att::LDS_BIAS) + 64;
                for (int u = vcu; u < NU; u += G) {
                    int b, h, row0, NT, R0 = 0, krlo = 0;
                    if (u < NUL) { const int qb = u & 15; h = (u >> 4) & 31; b = u >> 9; row0 = b * SEQ + qb * 256; R0 = 4 * qb;
                        krlo = R0 - 4; krlo = krlo < 0 ? 0 : (krlo > 56 ? 56 : krlo); int krhi = R0 - 1; krhi = krhi < 0 ? 0 : (krhi > 56 ? 56 : krhi); krhi += 7; NT = 4 + (krhi - krlo + 1); }
                    else { const int v = u - NUL; h = v & 31; b = v >> 5; row0 = MLAT + b * CTX; NT = 4; }
                    __syncthreads();
                    const int t2 = wave_id * 64 + att::lane_opq();
                    if (t2 < 15 * 32) { const int ri = t2 >> 5, ci = t2 & 31; btab[t2] = ci < 31 ? INP(I_NA_RPB)[(h * 15 + ri) * 31 + ci] * LOG2E : 0.f; }
                    att::Src S; S.Q = QKV + (size_t)row0 * 12288 + h * 128; S.ldq = 12288; S.K1 = QKV + 4096 + h * 128; S.ldk1 = 12288; S.K2 = nullptr; S.ldk2 = 0;
                    S.V = QKV + 8192 + h * 128; S.ldv = 12288; S.ctx_row0 = MLAT + b * CTX; S.lat_row0 = b * SEQ + 64 * krlo; S.NT = NT;
                    f32x16 o[4]; float l_reg; float rli[16];
                    att::attn_core<128, 1>(S, Cs, ring, o, l_reg, wave_id, 0, R0 + (wave >> 1), krlo, (wave & 1) * 32 + (att::lane_opq() & 31));
                    att::row_recip(l_reg, ring, rli, wave_id);
                    att::store_o(o, rli, OB + (size_t)(row0 + wave * 32) * 4096 + h * 128, 4096);
                }
            }
#endif
#ifdef PROBE_ATT2
        }
#endif
        }
        SEAM(pb + 3);
        } else {
#ifndef SKIP_G6
        if (IN(pb + 6)) {
            PHASE_IDS();
            pg8::Gemm g{H, (const bf16_t*)(ARG_WS() + WS_W1 + l * SZ_W1), Mrows, DFF, 4096, 4096, 4096}; pg8::StaticOrder S; S.init(Mrows, DFF, G, bx);
            pg8::EpiBf16<1> E{BIG, DFF};
            pg8::gemm_phase<pg8::EpiBf16<1>, pg8::StaticOrder, true, true>(ring, g, S, E, wave_id);
            if (with_ctx) CVT_WINDOW(l == 0 ? cvs::win_lo(1) : (l == 1 ? cvs::win_lo(4) : cvs::win_lo(6)), l == 0 ? cvs::win_hi(1) : (l == 1 ? cvs::win_hi(4) : cvs::win_hi(6)), (34 * 64) % G);
        }
#endif
        SEAM(pb + 6);
        }
        const int pr = pb + 4 + 3 * sub;
#ifndef SKIP_G4
        if (IN(pr)) {
            PHASE_IDS();
            const bf16_t* Wt = sub ? (const bf16_t*)(ARG_WS() + WS_W2 + l * SZ_W1)
                                   : (kind == 0 ? (const bf16_t*)(ARG_WS() + WS_WO_DA + slot * SZ_WO) : (kind == 1 ? (const bf16_t*)(ARG_WS() + WS_WOMLA) : (const bf16_t*)(ARG_WS() + WS_WO_NA)));
            const bf16_t* Ain = sub ? BIG : OB; const int Kr = sub ? DFF : o_ld;
            { pg8::Gemm g{Ain, Wt, MLAT, 4096, Kr, Kr, Kr}; pg8::StaticOrder S; S.init(MLAT, 4096, G, bx);
              const int pln = 2 * l + sub - 1;
              pg8::EpiResid E{modl + (2 + 3 * sub) * 4096, DN_ALPHA, pln};
              pg8::gemm_phase<pg8::EpiResid, pg8::StaticOrder, true, true>(ring, g, S, E, wave_id); }
            if (with_ctx) {
              pg8::Gemm g{Ain + (size_t)MLAT * Kr, Wt, MCTX, 4096, Kr / 8, Kr, Kr}; pg8::SplitKOrder S; S.init(MCTX, 4096, 8, G, bx);
              pg8::EpiSlabBf16 E{(bf16_t*)(ARG_WS() + WS_PART)};
              pg8::gemm_phase<pg8::EpiSlabBf16, pg8::SplitKOrder, true, true>(ring, g, S, E, wave_id); }
        }
#endif
        SEAM(pr);
        if (IN(pr + 1)) {
            PHASE_IDS();
            const float* gg = INP(I_LN_G) + (size_t)(l * 2 + sub) * D; const float* bb = INP(I_LN_B) + (size_t)(l * 2 + sub) * D;
            const bool last = (sub == 1) && (l + 1 == DEPTH);
            const float* modn = sub ? MOD + (size_t)(l + 1 < DEPTH ? l + 1 : l) * 3 * 24576 : modl;
            const int isc = sub ? 1 : 4, ish = sub ? 0 : 3;
            const float* gate = modl + (size_t)2 * 24576 + (2 + 3 * sub) * 4096;
            LAS float* lt = (LAS float*)ring;
            for (int i = tid; i < 3 * 4096; i += 512) { const int c = i >> 12, col = i & 4095; const float g_ = gg[col], b_ = bb[col];
                float sc_ = 0.f, sh_ = 0.f; if (!last) { const float* m = modn + (size_t)c * 24576; sc_ = m[isc * 4096 + col]; sh_ = m[ish * 4096 + col]; }
                lt[(c * 2 + 0) * 4096 + col] = g_ * (1.f + sc_); lt[(c * 2 + 1) * 4096 + col] = b_ * (1.f + sc_) + sh_; }
            __syncthreads();
            int r_lo = gw, r_hi = Mrows, r_st = NGW;
            if (with_ctx) { if (wave < 2) { r_lo = MLAT + vcu * 2 + wave; r_hi = MALL; r_st = 2 * G; } else { r_lo = vcu * 6 + wave - 2; r_hi = MLAT; r_st = 6 * G; } }
            const int pln = 2 * l + sub - 1;
            if (!last) ln_rows<false>(r_lo, r_hi, r_st, X, H, nullptr, (float*)(ARG_WS() + WS_STATS), lt, lane, with_ctx ? (const bf16_t*)(ARG_WS() + WS_PART) : nullptr, gate, DN_ALPHA,
                                      pln >= 0, INP(I_LN_G) + (size_t)(pln >= 0 ? pln : 0) * D, INP(I_LN_B) + (size_t)(pln >= 0 ? pln : 0) * D);
            else ln_rows<true>(r_lo, r_hi, r_st, X, nullptr, ARG_OUT(), nullptr, lt, lane, nullptr, nullptr, 0.f, false, nullptr, nullptr);
        }
        if (sl + 1 < 2 * DEPTH) SEAM(pr + 1);
    }
#undef IN
#undef SEAM
}

#undef INP
#undef ARG_OUT
#undef ARG_WS
#undef tab
#undef tpart
#undef MOD
#undef X
#undef H
#undef QKV
#undef BIG
#undef DOWN
#undef CQ
#undef CKV
#undef KR
#undef OB
extern "C" void kernel_launch(void* const* d_in, const int* in_sizes, int n_in, void* d_out, int out_size, void* d_ws, size_t ws_size, hipStream_t stream) {
    using namespace cfg;
    static int grid = 0;
    if (grid == 0) {
        if (n_in != 27 || in_sizes[0] != MLAT * D || out_size != MLAT * D || ws_size < WS_END) {
            fprintf(stderr, "kernel_launch: shape mismatch: n_in %d in0 %d out %d ws %zu (need %zu); nothing launched\n", n_in, n_in > 0 ? in_sizes[0] : -1, out_size, ws_size, (size_t)WS_END); grid = -1; return; }
        int dev = 0, cus = 0, per_cu = 0;
        if (hipGetDevice(&dev) != hipSuccess || hipDeviceGetAttribute(&cus, hipDeviceAttributeMultiprocessorCount, dev) != hipSuccess) { fprintf(stderr, "kernel_launch: device query failed\n"); grid = -1; return; }
        if (hipFuncSetAttribute((const void*)fwd, hipFuncAttributeMaxDynamicSharedMemorySize, LDS_BYTES) != hipSuccess) { fprintf(stderr, "kernel_launch: hipFuncSetAttribute(%d B LDS) failed\n", LDS_BYTES); grid = -1; return; }
        if (hipOccupancyMaxActiveBlocksPerMultiprocessor(&per_cu, (const void*)fwd, 512, LDS_BYTES) != hipSuccess || per_cu < 1) {
            fprintf(stderr, "kernel_launch: occupancy query reports %d workgroups per CU\n", per_cu); }
        (void)hipGetLastError();
        grid = cus;
    }
    if (grid < 0) return;
    if (hipMemsetAsync((char*)d_ws + WS_CTL, 0, CTL_ZERO_BYTES, stream) != hipSuccess) { fprintf(stderr, "kernel_launch: memset failed\n"); return; }
    Args a{};
    for (int i = 0; i < 27; ++i) a.in[i] = (const float*)d_in[i];
    a.out = (float*)d_out; a.ws = (unsigned char*)d_ws;
#if MK_ONE_LAUNCH
    a.ph_lo = 0; a.ph_hi = PH_END;
    hipLaunchKernelGGL(fwd, dim3(grid), dim3(512), LDS_BYTES, stream, a);
#else
    for (int p = 0; p < PH_END; ++p) {
        if (p >= PH_L0) { const int l = (p - PH_L0) / PH_PER_LAYER, k = (p - PH_L0) % PH_PER_LAYER; if (k == 9) continue; if ((k == 1 || k == 2) && (l % 3) != 1) continue; }
        a.ph_lo = p; a.ph_hi = p + 1;
#ifdef PROBE_REP_PHASE
        if (p >= PH_L0 && (p - PH_L0) % PH_PER_LAYER == PROBE_REP_PHASE) {
#ifdef PROBE_VAR
            a.var = PROBE_VAR;
#endif
            hipLaunchKernelGGL(fwd, dim3(grid), dim3(512), LDS_BYTES, stream, a); a.var = 0; }
#endif
        hipLaunchKernelGGL(fwd, dim3(grid), dim3(512), LDS_BYTES, stream, a);
#ifdef PROBE_REP_PHASE_UNUSED
#endif
    }
#endif
    const hipError_t le = hipPeekAtLastError();
    if (le != hipSuccess) fprintf(stderr, "kernel_launch: launch failed: %s\n", hipGetErrorName(le));
}
```

```cpp
#include <hip/hip_runtime.h>
#include <cstdio>
#include <cstdint>

#define GAS __attribute__((address_space(1)))
#define LAS __attribute__((address_space(3)))
typedef short s16x4 __attribute__((ext_vector_type(4)));
typedef float f32x16 __attribute__((ext_vector_type(16)));
typedef unsigned u32x2 __attribute__((ext_vector_type(2)));

#ifndef MK_ONE_LAUNCH
#define MK_ONE_LAUNCH 1
#endif

namespace cfg {
constexpr int D = 4096, NB = 2, SEQ = 4096, CTX = 256, DFF = 16384, DEPTH = 4;
constexpr int MLAT = NB * SEQ, MCTX = NB * CTX, MALL = MLAT + MCTX;
constexpr int ADA_R = 512, NMOD = 6;
constexpr float DN_ALPHA = 1.6817928305074290f;
constexpr float LN_EPS = 1e-5f, RMS_EPS = 1e-6f;
constexpr int MLA_QR = 1536, MLA_KVR = 512, MLA_DOWN = 2112, MLA_DOWN_PAD = 2304;
constexpr float LOG2E = 1.4426950408889634f;
constexpr size_t MiB = 1u << 20;
constexpr size_t WS_CTL = 0, CTL_ZERO_BYTES = 1 * MiB;
constexpr size_t WS_TAB = 1 * MiB;
constexpr size_t WS_TPART = 1 * MiB + 65536;
constexpr size_t WS_MOD = 2 * MiB;
constexpr size_t WS_W = 4 * MiB;
constexpr size_t SZ_WQKV = (size_t)12288 * 4096 * 2, SZ_WO = (size_t)4096 * 4096 * 2, SZ_WDOWN = (size_t)MLA_DOWN_PAD * 4096 * 2;
constexpr size_t SZ_WUQ = (size_t)12288 * 1536 * 2, SZ_WUKV = (size_t)16384 * 512 * 2, SZ_WOMLA = (size_t)4096 * 8192 * 2, SZ_W1 = (size_t)16384 * 4096 * 2;
constexpr size_t WS_WQKV_DA = WS_W;
constexpr size_t WS_WO_DA = WS_WQKV_DA + 2 * SZ_WQKV;
constexpr size_t WS_WDOWN = WS_WO_DA + 2 * SZ_WO;
constexpr size_t WS_WUQ = WS_WDOWN + SZ_WDOWN;
constexpr size_t WS_WUKV = WS_WUQ + SZ_WUQ;
constexpr size_t WS_WOMLA = WS_WUKV + SZ_WUKV;
constexpr size_t WS_WQKV_NA = WS_WOMLA + SZ_WOMLA;
constexpr size_t WS_WO_NA = WS_WQKV_NA + SZ_WQKV;
constexpr size_t WS_W1 = WS_WO_NA + SZ_WO;
constexpr size_t WS_W2 = WS_W1 + 4 * SZ_W1;
constexpr size_t WS_X = WS_W2 + 4 * SZ_W1;
constexpr size_t WS_H = WS_X + (size_t)MALL * D * 4;
constexpr size_t WS_QKV = WS_H + (size_t)MALL * D * 2;
constexpr size_t WS_BIG = WS_QKV + (size_t)MALL * 12288 * 2;
constexpr size_t WS_DOWN = WS_BIG + (size_t)MALL * 16384 * 2;
constexpr size_t WS_CQ = WS_DOWN + (size_t)MALL * MLA_DOWN_PAD * 4;
constexpr size_t WS_CKV = WS_CQ + (size_t)MALL * MLA_QR * 2;
constexpr size_t WS_KR = WS_CKV + (size_t)MALL * MLA_KVR * 2;
constexpr size_t WS_O = WS_KR + (size_t)MALL * 64 * 2;
constexpr size_t WS_STASH = WS_O + (size_t)MALL * 8192 * 2;
constexpr size_t WS_PART = WS_STASH + (size_t)256 * 32768 * 4;
constexpr size_t WS_STATS = WS_PART + (size_t)8 * 512 * 4096 * 4;
constexpr size_t WS_END = WS_STATS + (size_t)MALL * 2 * 4;
static_assert(WS_TPART + 4 * 8 * 3 * 512 * 4 <= WS_MOD && WS_MOD + 4 * 3 * 6 * 4096 * 4 <= WS_W, "ws map");
static_assert(WS_X % 256 == 0 && WS_END < (size_t)4200 * MiB, "ws map");
constexpr int LDSCTL_BYTES = 1024;
constexpr int RING_OFF = LDSCTL_BYTES, RING_BYTES = 147456;
constexpr int LDS_BYTES = RING_OFF + RING_BYTES;
constexpr int PH_CVT = 0, PH_MOD = 1, PH_INIT = 2, PH_L0 = 3, PH_PER_LAYER = 10, PH_END = PH_L0 + PH_PER_LAYER * DEPTH;
}
#define CAS __attribute__((address_space(4)))
typedef const CAS char* kptr_t;
__device__ __forceinline__ kptr_t karg_base() { kptr_t kp = (kptr_t)__builtin_amdgcn_kernarg_segment_ptr(); asm volatile("" : "+s"(kp)); return kp; }
#define INP(i) (*(const float* const CAS*)(karg_base() + 8 * (i)))
#define ARG_OUT() (*(float* const CAS*)(karg_base() + 216))
#define ARG_WS() (*(unsigned char* const CAS*)(karg_base() + 224))
typedef _Float16 h16_t;
__device__ __forceinline__ unsigned pk_h16(float a, float b) { return __builtin_bit_cast(unsigned, __builtin_amdgcn_cvt_pkrtz(a, b)); }
__device__ __forceinline__ float h16_lo(unsigned w) { return (float)__builtin_bit_cast(_Float16, (unsigned short)(w & 0xffffu)); }
__device__ __forceinline__ float h16_hi(unsigned w) { return (float)__builtin_bit_cast(_Float16, (unsigned short)(w >> 16)); }
namespace pg8 {
#define PG8_LAS __attribute__((address_space(3)))
typedef unsigned short bf16_t;
typedef short bf16x8 __attribute__((ext_vector_type(8)));
typedef float f32x4 __attribute__((ext_vector_type(4)));
typedef unsigned u32x4 __attribute__((ext_vector_type(4)));
constexpr int BM = 256, BK = 64, HALF = 128, HTB = HALF * BK * 2  , STAGE_BYTES = 8 * HTB, NXCD = 8, WGM = 8;

__host__ __device__ __forceinline__ int lds_byte(int r, int c) { const int st = (r >> 4) * 2 + (c >> 5), rr = r & 15, cc = c & 31, ob = rr * 64 + cc * 2; return st * 1024 + (ob ^ (((ob >> 9) & 1) << 5)); }
__host__ __device__ __forceinline__ void stage_rc(int b, int& R, int& C) { const int st = b / 1024, sb = b % 1024, swz = sb ^ (((sb >> 9) & 1) << 5); R = (st >> 1) * 16 + swz / 64; C = (st & 1) * 32 + (swz % 64) / 2; }
__host__ __device__ __forceinline__ int perm32(int rho) { const int n = rho >> 4, i = rho & 15; return 8 * (i >> 2) + 4 * n + (i & 3); }

struct Unit { int pm, pn, ks; };
struct Gemm { const bf16_t* A; const bf16_t* Bt; int M, N, K, lda, ldb; };

struct StaticOrder {
    int nM, nN, nwg, G, c;
    __host__ __device__ void init(int M, int N, int G_, int c_) { nM = M / BM; nN = N / BM; nwg = nM * nN; G = G_; c = c_; }
    __host__ __device__ bool next(int i, Unit& u) const {
        const int L = i * G + c; if (L >= nwg) return false;
        int wgid = L; { const int q = nwg / NXCD, r = nwg % NXCD, xcd = wgid % NXCD, off = wgid / NXCD; wgid = (xcd < r ? xcd * (q + 1) : r * (q + 1) + (xcd - r) * q) + off; }
        const int nig = WGM * nN, gid = wgid / nig, fm = gid * WGM, gsz = (nM - fm) < WGM ? (nM - fm) : WGM;
        u.pm = fm + ((wgid % nig) % gsz); u.pn = (wgid % nig) / gsz; u.ks = 0; return true;
    }
    __device__ __forceinline__ void a_ready(const Unit&) const {}
    __device__ __forceinline__ void done(const Unit&) const {}
};
struct SplitKOrder {
    int nM, nN, nS, G, c;
    __host__ __device__ void init(int M, int N, int nS_, int G_, int c_) { nM = M / BM; nN = N / BM; nS = nS_; G = G_; c = c_; }
    __host__ __device__ bool next(int i, Unit& u) const {
        const int L = i * G + c; if (L >= nM * nN * nS) return false;
        u.ks = L % nS; const int t = L / nS; u.pm = t % nM; u.pn = t / nM; return true;
    }
    __device__ __forceinline__ void a_ready(const Unit&) const {}
    __device__ __forceinline__ void done(const Unit&) const {}
};
__device__ __forceinline__ unsigned cvt_pk_bf16(float lo, float hi) { unsigned r; asm volatile("v_cvt_pk_bf16_f32 %0, %1, %2" : "=v"(r) : "v"(lo), "v"(hi)); return r; }
#ifndef EPI_NT
#define EPI_NT 0
#endif
#if EPI_NT
#define EPI_STORE(p, v) __builtin_nontemporal_store((v), (p))
#else
#define EPI_STORE(p, v) (*(p) = (v))
#endif
#define EPI_LOAD(p) __builtin_nontemporal_load(p)
template <int ACT  > struct EpiBf16 {
    static constexpr bool PERM = true, AFTER_DRAIN = false;
    bf16_t* O; int ldc;
    __device__ __forceinline__ void operator()(const f32x4 (&acc)[2][2][4][2], const Unit& u, int wr, int wc, int fr, int fq) const {
        const int row0 = u.pm * BM + wr * 64 + fr; const int col0 = u.pn * BM + wc * 32 + 8 * fq;
#pragma unroll
        for (int ai = 0; ai < 2; ++ai)
#pragma unroll
            for (int m = 0; m < 4; ++m) { bf16_t* rowp = O + (size_t)(row0 + ai * HALF + m * 16) * ldc + col0;
#pragma unroll
                for (int bj = 0; bj < 2; ++bj) { f32x4 v0 = acc[ai][bj][m][0], v1 = acc[ai][bj][m][1];
                    if (ACT == 1) {
#pragma unroll
                        for (int j = 0; j < 4; ++j) { const float a = fmaxf(v0[j], 0.f), b = fmaxf(v1[j], 0.f); v0[j] = a * a; v1[j] = b * b; } }
                    u32x4 w; w.x = cvt_pk_bf16(v0[0], v0[1]); w.y = cvt_pk_bf16(v0[2], v0[3]); w.z = cvt_pk_bf16(v1[0], v1[1]); w.w = cvt_pk_bf16(v1[2], v1[3]);
                    EPI_STORE((u32x4*)(rowp + bj * HALF), w); } }
    }
};
template <int KIND> struct EpiRope {
    static constexpr bool PERM = true, AFTER_DRAIN = false;
    bf16_t* O; int ldc; const float* tab; int rope_cols; int qcols; float qscale;
    __device__ __forceinline__ void operator()(const f32x4 (&acc)[2][2][4][2], const Unit& u, int wr, int wc, int fr, int fq) const {
        const int row0 = u.pm * BM + wr * 64 + fr; const int col0 = u.pn * BM + wc * 32 + 8 * fq;
        const bool lat = u.pm < 32;
        const float sgn = fq < 2 ? -1.f : 1.f;
        const float qs = (u.pn * BM < qcols) ? qscale : 1.f;
#pragma unroll
        for (int ai = 0; ai < 2; ++ai)
#pragma unroll
            for (int m = 0; m < 4; ++m) { const int row = row0 + ai * HALF + m * 16; bf16_t* rowp = O + (size_t)row * ldc + col0;
                const int s = row & 4095, pos = (wc & 1) ? (s & 63) : (s >> 6);
                const float* tp = tab + pos * 16 + 8 * (fq & 1);
                f32x4 c0 = {1.f, 1.f, 1.f, 1.f}, c1 = c0, s0 = {0.f, 0.f, 0.f, 0.f}, s1 = s0;
                if (lat) { c0 = *(const f32x4*)tp; c1 = *(const f32x4*)(tp + 4); s0 = *(const f32x4*)(tp + 1024); s1 = *(const f32x4*)(tp + 1028); }
#pragma unroll
                for (int bj = 0; bj < 2; ++bj) { f32x4 v0 = acc[ai][bj][m][0], v1 = acc[ai][bj][m][1];
                    const bool rope = lat && (KIND == 0 ? (u.pn * BM < rope_cols) : (((4 * u.pn + 2 * bj + (wc >> 1)) % 3) == 2));
                    if (rope) {
                        f32x4 p0, p1;
#pragma unroll
                        for (int j = 0; j < 4; ++j) { p0[j] = __shfl_xor(v0[j], 32); p1[j] = __shfl_xor(v1[j], 32); }
                        v0 = v0 * c0 + (p0 * s0) * sgn; v1 = v1 * c1 + (p1 * s1) * sgn; }
                    v0 = v0 * qs; v1 = v1 * qs;
                    u32x4 w; w.x = cvt_pk_bf16(v0[0], v0[1]); w.y = cvt_pk_bf16(v0[2], v0[3]); w.z = cvt_pk_bf16(v1[0], v1[1]); w.w = cvt_pk_bf16(v1[2], v1[3]);
                    EPI_STORE((u32x4*)(rowp + bj * HALF), w); } }
    }
};
struct EpiF32 {
    static constexpr bool PERM = false, AFTER_DRAIN = false;
    float* C; int ldc;
    __device__ __forceinline__ void operator()(const f32x4 (&acc)[2][2][4][2], const Unit& u, int wr, int wc, int fr, int fq) const {
        const int row0 = u.pm * BM + wr * 64 + fr, col0 = u.pn * BM + wc * 32 + 4 * fq;
#pragma unroll
        for (int ai = 0; ai < 2; ++ai)
#pragma unroll
            for (int m = 0; m < 4; ++m) { float* rowp = C + (size_t)(row0 + ai * HALF + m * 16) * ldc + col0;
#pragma unroll
                for (int bj = 0; bj < 2; ++bj)
#pragma unroll
                    for (int n = 0; n < 2; ++n) EPI_STORE((f32x4*)(rowp + bj * HALF + n * 16), acc[ai][bj][m][n]); }
    }
};
struct EpiResid {
    static constexpr bool PERM = true, AFTER_DRAIN = false;
    const float* gate; float alpha; int pln;
    __device__ __forceinline__ void operator()(const f32x4 (&acc)[2][2][4][2], const Unit& u, int wr, int wc, int fr, int fq) const {
        const int row0 = u.pm * BM + wr * 64 + fr, col0 = u.pn * BM + wc * 32 + 8 * fq;
        h16_t* X = (h16_t*)(ARG_WS() + cfg::WS_X); const float* stats = pln >= 0 ? (const float*)(ARG_WS() + cfg::WS_STATS) : nullptr;
        const float* lng = INP(7  ) + (size_t)(pln >= 0 ? pln : 0) * 4096; const float* lnb = INP(8  ) + (size_t)(pln >= 0 ? pln : 0) * 4096;
        const int cond = u.pm < 16 ? 0 : (u.pm < 32 ? 1 : 2);
        const float* gp = gate + (size_t)cond * (6 * 4096) + col0;
        f32x4 gv[2][2], lg[2][2], lb[2][2];
#pragma unroll
        for (int bj = 0; bj < 2; ++bj)
#pragma unroll
            for (int n = 0; n < 2; ++n) { gv[bj][n] = *(const f32x4*)(gp + bj * HALF + n * 4);
                if (stats) { lg[bj][n] = *(const f32x4*)(lng + col0 + bj * HALF + n * 4) * alpha; lb[bj][n] = *(const f32x4*)(lnb + col0 + bj * HALF + n * 4) * alpha; }
                else { lg[bj][n] = (f32x4){alpha, alpha, alpha, alpha}; lb[bj][n] = (f32x4){0.f, 0.f, 0.f, 0.f}; } }
        constexpr int EPI_PF = 1;
        const float* statp = (const float*)(ARG_WS() + cfg::WS_STATS);
        u32x4 zb[EPI_PF + 1][2]; float2 sb[EPI_PF + 1];
#define EPI_RS_LOAD(g_) do { const int row_ = row0 + ((g_) >> 2) * HALF + ((g_) & 3) * 16; const h16_t* rowi_ = X + (size_t)row_ * 4096 + col0; \
            sb[(g_) % (EPI_PF + 1)] = *(const float2*)(statp + 2 * row_);        \
            _Pragma("unroll") for (int bj = 0; bj < 2; ++bj) zb[(g_) % (EPI_PF + 1)][bj] = EPI_LOAD((const u32x4*)(rowi_ + bj * HALF)); } while (0)
#pragma unroll
        for (int g = 0; g < EPI_PF; ++g) EPI_RS_LOAD(g);
#pragma unroll
        for (int g = 0; g < 8; ++g) { const int ai = g >> 2, m = g & 3; const int row = row0 + ai * HALF + m * 16; h16_t* rowp = X + (size_t)row * 4096 + col0;
            if (g + EPI_PF < 8) EPI_RS_LOAD(g + EPI_PF);
            asm volatile("" ::: "memory"); __builtin_amdgcn_sched_barrier(0);
            const float mean = stats ? sb[g % (EPI_PF + 1)].x : 0.f, rstd = stats ? sb[g % (EPI_PF + 1)].y : 1.f;
#pragma unroll
            for (int bj = 0; bj < 2; ++bj) { const u32x4 zw = zb[g % (EPI_PF + 1)][bj];
                const f32x4 z0 = {h16_lo(zw.x), h16_hi(zw.x), h16_lo(zw.y), h16_hi(zw.y)}, z1 = {h16_lo(zw.z), h16_hi(zw.z), h16_lo(zw.w), h16_hi(zw.w)};
                const f32x4 o0 = ((z0 - mean) * rstd) * lg[bj][0] + lb[bj][0] + gv[bj][0] * acc[ai][bj][m][0];
                const f32x4 o1 = ((z1 - mean) * rstd) * lg[bj][1] + lb[bj][1] + gv[bj][1] * acc[ai][bj][m][1];
                u32x4 w; w.x = pk_h16(o0[0], o0[1]); w.y = pk_h16(o0[2], o0[3]); w.z = pk_h16(o1[0], o1[1]); w.w = pk_h16(o1[2], o1[3]);
                EPI_STORE((u32x4*)(rowp + bj * HALF), w); }
            asm volatile("" ::: "memory"); __builtin_amdgcn_sched_barrier(0); }
#undef EPI_RS_LOAD
    }
};
struct EpiSlabBf16 {
    static constexpr bool PERM = true, AFTER_DRAIN = false;
    bf16_t* P;
    __device__ __forceinline__ void operator()(const f32x4 (&acc)[2][2][4][2], const Unit& u, int wr, int wc, int fr, int fq) const {
        const int row0 = u.pm * BM + wr * 64 + fr; const int col0 = u.pn * BM + wc * 32 + 8 * fq;
        bf16_t* base = P + (size_t)u.ks * (512 * 4096);
#pragma unroll
        for (int ai = 0; ai < 2; ++ai)
#pragma unroll
            for (int m = 0; m < 4; ++m) { bf16_t* rowp = base + (size_t)(row0 + ai * HALF + m * 16) * 4096 + col0;
#pragma unroll
                for (int bj = 0; bj < 2; ++bj) { const f32x4 v0 = acc[ai][bj][m][0], v1 = acc[ai][bj][m][1];
                    u32x4 w; w.x = cvt_pk_bf16(v0[0], v0[1]); w.y = cvt_pk_bf16(v0[2], v0[3]); w.z = cvt_pk_bf16(v1[0], v1[1]); w.w = cvt_pk_bf16(v1[2], v1[3]);
                    *(u32x4*)(rowp + bj * HALF) = w; } }
    }
};
struct EpiSlab {
    static constexpr bool PERM = false, AFTER_DRAIN = false;
    float* P;
    __device__ __forceinline__ void operator()(const f32x4 (&acc)[2][2][4][2], const Unit& u, int wr, int wc, int fr, int fq) const {
        const int row0 = u.pm * BM + wr * 64 + fr, col0 = u.pn * BM + wc * 32 + 4 * fq;
        float* base = P + (size_t)u.ks * (512 * 4096);
#pragma unroll
        for (int ai = 0; ai < 2; ++ai)
#pragma unroll
            for (int m = 0; m < 4; ++m) { float* rowp = base + (size_t)(row0 + ai * HALF + m * 16) * 4096 + col0;
#pragma unroll
                for (int bj = 0; bj < 2; ++bj)
#pragma unroll
                    for (int n = 0; n < 2; ++n) EPI_STORE((f32x4*)(rowp + bj * HALF + n * 16), acc[ai][bj][m][n]); }
    }
};
template <class Epi, class Sched, bool ALIGN_EPI = false, bool SP2 = false>
__device__ __forceinline__ void gemm_phase(PG8_LAS unsigned char* lds, const Gemm g, const Sched& S, const Epi& E, const int wave_id_) {
    int wave_id = wave_id_; asm volatile("" : "+s"(wave_id));
    int tid; { unsigned m_ = ~0u; asm volatile("" : "+s"(m_)); tid = wave_id * 64 + (int)__builtin_amdgcn_mbcnt_hi(m_, __builtin_amdgcn_mbcnt_lo(m_, 0u)); } asm volatile("" : "+v"(tid));
    const int wid = wave_id, lane = tid & 63, wr = wid >> 2, wc = wid & 3, fr = lane & 15, fq = lane >> 4;
    const int K = g.K, nt = K / BK;
    unsigned voffA[2], voffB[2];
#pragma unroll
    for (int i = 0; i < 2; ++i) { int R, C; stage_rc(tid * 16 + i * 8192, R, C); const int Rb = Epi::PERM ? ((R & ~31) + perm32(R & 31)) : R;
        voffA[i] = (unsigned)(R * g.lda + C) * 2u; voffB[i] = (unsigned)(Rb * g.ldb + C) * 2u; }
    const size_t kstep = (size_t)(BK * 2);
    const size_t hstepA = (size_t)HALF * g.lda * 2, hstepB = (size_t)HALF * g.ldb * 2;
    const size_t tstepA = 2 * hstepA, tstepB = 2 * hstepB;
    const unsigned ldsw = (unsigned)wid * 1024u;
    const int aoff = lds_byte(wr * 64 + fr, fq * 8), boff = lds_byte(wc * 32 + fr, fq * 8);
#define PG8_SA(b, h) (((b) * 2 + (h)) * HTB)
#define PG8_SB(b, h) ((4 + (b) * 2 + (h)) * HTB)
#define PG8_STAGE(bufoff, gbase, voff) do { _Pragma("unroll") for (int _i = 0; _i < 2; ++_i) \
        __builtin_amdgcn_global_load_lds((const unsigned*)((const char*)(gbase) + (voff)[_i]), (PG8_LAS unsigned*)(lds + (bufoff) + ldsw + _i * 8192), 16, 0, 0); } while (0)
#define PG8_LDA(dst, b, h) do { _Pragma("unroll") for (int m = 0; m < 4; ++m) _Pragma("unroll") for (int k = 0; k < 2; ++k) dst[m][k] = *(const PG8_LAS bf16x8*)(lds + PG8_SA(b, h) + aoff + m * 2048 + k * 1024); } while (0)
#define PG8_LDB(dst, b, h) do { _Pragma("unroll") for (int n = 0; n < 2; ++n) _Pragma("unroll") for (int k = 0; k < 2; ++k) dst[n][k] = *(const PG8_LAS bf16x8*)(lds + PG8_SB(b, h) + boff + n * 2048 + k * 1024); } while (0)
#define PG8_MMA(ai, bj, At, Bt) do { __builtin_amdgcn_s_setprio(1); _Pragma("unroll") for (int m = 0; m < 4; ++m) _Pragma("unroll") for (int n = 0; n < 2; ++n) _Pragma("unroll") for (int k = 0; k < 2; ++k) \
        acc[ai][bj][m][n] = __builtin_amdgcn_mfma_f32_16x16x32_bf16(Bt[n][k], At[m][k], acc[ai][bj][m][n], 0, 0, 0); __builtin_amdgcn_s_setprio(0); } while (0)
#define PG8_WAIT_V(n) asm volatile("s_waitcnt vmcnt(" #n ")" ::: "memory")
#define PG8_WAIT_L(n) asm volatile("s_waitcnt lgkmcnt(" #n ")" ::: "memory")
#define PG8_BAR __builtin_amdgcn_s_barrier()
#define PG8_SCHED __builtin_amdgcn_sched_barrier(0)
    Unit cur, nxt; int ui = 0;
    if (!S.next(0, cur)) return;
    f32x4 acc[2][2][4][2];
#pragma unroll
    for (int a = 0; a < 2; ++a)
#pragma unroll
        for (int b = 0; b < 2; ++b)
#pragma unroll
            for (int m = 0; m < 4; ++m)
#pragma unroll
                for (int n = 0; n < 2; ++n) acc[a][b][m][n] = (f32x4){0.f, 0.f, 0.f, 0.f};
    bf16x8 At[4][2], B0[2][2], B1[2][2];
    const char* cA = (const char*)g.A + (size_t)cur.pm * tstepA + (size_t)cur.ks * K * 2; const char* cB = (const char*)g.Bt + (size_t)cur.pn * tstepB + (size_t)cur.ks * K * 2;
    S.a_ready(cur);
    if constexpr (SP2) {
        PG8_STAGE(PG8_SB(0, 0), cB, voffB); PG8_STAGE(PG8_SB(0, 1), cB + hstepB, voffB); PG8_STAGE(PG8_SA(0, 0), cA, voffA); PG8_STAGE(PG8_SA(0, 1), cA + hstepA, voffA);
        if (wr == 1) PG8_BAR;
        PG8_WAIT_V(2); PG8_BAR;
        PG8_STAGE(PG8_SB(1, 0), cB + kstep, voffB); PG8_STAGE(PG8_SA(1, 0), cA + kstep, voffA); PG8_STAGE(PG8_SB(1, 1), cB + hstepB + kstep, voffB);
        PG8_WAIT_V(6); PG8_BAR;
    } else {
        PG8_STAGE(PG8_SB(0, 0), cB, voffB); PG8_STAGE(PG8_SA(0, 0), cA, voffA); PG8_STAGE(PG8_SB(0, 1), cB + hstepB, voffB); PG8_STAGE(PG8_SA(0, 1), cA + hstepA, voffA);
        if (wr == 1) PG8_BAR;
        PG8_WAIT_V(4); PG8_BAR;
        PG8_STAGE(PG8_SB(1, 0), cB + kstep, voffB); PG8_STAGE(PG8_SA(1, 0), cA + kstep, voffA); PG8_STAGE(PG8_SB(1, 1), cB + hstepB + kstep, voffB);
        PG8_WAIT_V(6); PG8_BAR;
    }
    for (;;) {
        const bool has_next = S.next(ui + 1, nxt);
        const char* nA = has_next ? (const char*)g.A + (size_t)nxt.pm * tstepA + (size_t)nxt.ks * K * 2 : cA; const char* nB = has_next ? (const char*)g.Bt + (size_t)nxt.pn * tstepB + (size_t)nxt.ks * K * 2 : cB;
        for (int t = 0; t < nt; t += 2) {
            const bool last = (t == nt - 2);
            const char* a1 = cA + (size_t)(t + 1) * kstep;
            const char* a2 = last ? nA : cA + (size_t)(t + 2) * kstep; const char* b2 = last ? nB : cB + (size_t)(t + 2) * kstep;
            const char* a3 = a2 + kstep; const char* b3 = b2 + kstep;
            if (last && has_next) S.a_ready(nxt);
            if constexpr (SP2) {
            PG8_LDB(B0, 0, 0); PG8_LDB(B1, 0, 1); PG8_SCHED; PG8_LDA(At, 0, 0); PG8_STAGE(PG8_SA(1, 1), a1 + hstepA, voffA);
            PG8_WAIT_V(8); PG8_WAIT_L(0); PG8_BAR; PG8_MMA(0, 0, At, B0); PG8_MMA(0, 1, At, B1); PG8_BAR; PG8_SCHED;
            PG8_LDA(At, 0, 1); PG8_STAGE(PG8_SB(0, 0), b2, voffB); PG8_STAGE(PG8_SB(0, 1), b2 + hstepB, voffB); PG8_STAGE(PG8_SA(0, 0), a2, voffA);
            PG8_WAIT_V(8); PG8_WAIT_L(0); PG8_BAR; PG8_MMA(1, 0, At, B0); PG8_MMA(1, 1, At, B1); PG8_BAR; PG8_SCHED;
            PG8_LDB(B0, 1, 0); PG8_LDB(B1, 1, 1); PG8_SCHED; PG8_LDA(At, 1, 0); PG8_STAGE(PG8_SA(0, 1), a2 + hstepA, voffA);
            PG8_WAIT_V(8); PG8_WAIT_L(0); PG8_BAR; PG8_MMA(0, 0, At, B0); PG8_MMA(0, 1, At, B1); PG8_BAR; PG8_SCHED;
            PG8_LDA(At, 1, 1); PG8_STAGE(PG8_SB(1, 0), b3, voffB); PG8_STAGE(PG8_SB(1, 1), b3 + hstepB, voffB); PG8_STAGE(PG8_SA(1, 0), a3, voffA);
            PG8_WAIT_V(8); PG8_WAIT_L(0); PG8_BAR; PG8_MMA(1, 0, At, B0); PG8_MMA(1, 1, At, B1); PG8_BAR; PG8_SCHED;
            } else {
            PG8_LDB(B0, 0, 0); PG8_SCHED; PG8_LDA(At, 0, 0); PG8_STAGE(PG8_SA(1, 1), a1 + hstepA, voffA);
            PG8_WAIT_L(8); PG8_BAR; PG8_WAIT_L(0); PG8_MMA(0, 0, At, B0); PG8_BAR; PG8_SCHED;
            PG8_LDB(B1, 0, 1); PG8_STAGE(PG8_SB(0, 0), b2, voffB);
            PG8_BAR; PG8_WAIT_L(0); PG8_MMA(0, 1, At, B1); PG8_BAR;
            PG8_LDA(At, 0, 1); PG8_STAGE(PG8_SA(0, 0), a2, voffA);
            PG8_BAR; PG8_WAIT_L(0); PG8_MMA(1, 0, At, B0); PG8_BAR; PG8_SCHED;
            PG8_STAGE(PG8_SB(0, 1), b2 + hstepB, voffB);
            PG8_WAIT_V(6); PG8_BAR; PG8_MMA(1, 1, At, B1); PG8_BAR;
            PG8_LDB(B0, 1, 0); PG8_SCHED; PG8_LDA(At, 1, 0); PG8_STAGE(PG8_SA(0, 1), a2 + hstepA, voffA);
            PG8_WAIT_L(8); PG8_BAR; PG8_WAIT_L(0); PG8_MMA(0, 0, At, B0); PG8_BAR; PG8_SCHED;
            PG8_LDB(B1, 1, 1); PG8_STAGE(PG8_SB(1, 0), b3, voffB);
            PG8_BAR; PG8_WAIT_L(0); PG8_MMA(0, 1, At, B1); PG8_BAR;
            PG8_LDA(At, 1, 1); PG8_STAGE(PG8_SA(1, 0), a3, voffA);
            PG8_BAR; PG8_WAIT_L(0); PG8_MMA(1, 0, At, B0); PG8_BAR; PG8_SCHED;
            PG8_STAGE(PG8_SB(1, 1), b3 + hstepB, voffB);
            PG8_WAIT_V(6); PG8_BAR; PG8_MMA(1, 1, At, B1); PG8_BAR;
            }
        }
        if constexpr (ALIGN_EPI) { if (wr == 0) PG8_BAR; }
        if constexpr (!Epi::AFTER_DRAIN) { E(acc, cur, wr, wc, fr, fq); S.done(cur); }
        if (!has_next) break;
#pragma unroll
        for (int a = 0; a < 2; ++a)
#pragma unroll
            for (int b = 0; b < 2; ++b)
#pragma unroll
                for (int m = 0; m < 4; ++m)
#pragma unroll
                    for (int n = 0; n < 2; ++n) acc[a][b][m][n] = (f32x4){0.f, 0.f, 0.f, 0.f};
        cur = nxt; cA = nA; cB = nB; ++ui;
        if constexpr (ALIGN_EPI) { if (wr == 1) PG8_BAR; }
    }
    PG8_WAIT_V(0);
    if constexpr (!ALIGN_EPI) { if (wr == 0) PG8_BAR; }
    PG8_BAR;
    if constexpr (Epi::AFTER_DRAIN) { E.fused(acc, cur, wr, wc, fr, fq, lds, wid, lane); S.done(cur); }
#undef PG8_SA
#undef PG8_SB
#undef PG8_STAGE
#undef PG8_LDA
#undef PG8_LDB
#undef PG8_MMA
#undef PG8_WAIT_V
#undef PG8_WAIT_L
#undef PG8_BAR
#undef PG8_SCHED
}
}
#define XB_TMO      128
#define XB_XCNT(j)  (256  + 64 * (j))
#define XB_XSUB(j)  (1280 + 64 * (j))
#define XB_XGEN(j)  (2304 + 64 * (j))
#define XB_TOP      3328
#define XB_TOPGEN   3392
#define XCD_BAR_WORDS 3456
#define XB_SPIN_CAP (1u << 18)

__device__ __forceinline__ unsigned xb_ld(unsigned* p)              { return __hip_atomic_load(p, __ATOMIC_RELAXED, __HIP_MEMORY_SCOPE_AGENT); }
__device__ __forceinline__ unsigned xb_add(unsigned* p, unsigned v) { return __hip_atomic_fetch_add(p, v, __ATOMIC_RELAXED, __HIP_MEMORY_SCOPE_AGENT); }
__device__ __forceinline__ unsigned xb_xcc_id() { return (unsigned)__builtin_amdgcn_s_getreg((3 << 11) | 20) & 0xFu; }
#define XB_SPIN(cond, bar) do { unsigned _sp = 0; while (cond) { __builtin_amdgcn_s_sleep(1); \
    if ((++_sp & 255u) == 0u) { if (xb_ld(&(bar)[XB_TMO])) break; if (_sp > XB_SPIN_CAP) { atomicAdd(&(bar)[XB_TMO], 1u); break; } } } } while (0)

struct XcdBarrier {
    unsigned* bar; unsigned x;
    volatile LAS unsigned* st;
};

__device__ __forceinline__ XcdBarrier xcd_barrier_post(unsigned* bar, volatile LAS unsigned* st, const bool is_t0  ) {
    XcdBarrier b; b.bar = bar; b.x = xb_xcc_id(); b.st = st;
    if (is_t0) (void)xb_add(&bar[XB_XCNT(b.x)], 1u);
    return b;
}
__device__ __forceinline__ void xcd_barrier_complete(unsigned* bar, unsigned x, unsigned& nloc, unsigned& nx) {
    const unsigned G = gridDim.x * gridDim.y * gridDim.z;
    unsigned sum, cnt, mine, sp = 0u;
    for (;;) {
        sum = 0u; cnt = 0u; mine = 0u;
#pragma unroll
        for (unsigned j = 0; j < 16; ++j) { const unsigned c = xb_ld(&bar[XB_XCNT(j)]); sum += c; cnt += (c > 0u) ? 1u : 0u; mine = (j == x) ? c : mine; }
        if (sum == G) break;
        __builtin_amdgcn_s_sleep(1);
        if ((++sp & 255u) == 0u) { if (xb_ld(&bar[XB_TMO])) break; if (sp > XB_SPIN_CAP) { atomicAdd(&bar[XB_TMO], 1u); break; } }
    }
    nloc = mine > 0u ? mine : 1u; nx = cnt > 0u ? cnt : 1u;
}

__device__ __forceinline__ void xcd_barrier(const XcdBarrier& b, const bool is_t0  ) {
    asm volatile("s_waitcnt vmcnt(0)" ::: "memory");
    __syncthreads();
    if (is_t0) {
        unsigned* bar = b.bar;
        __builtin_amdgcn_s_waitcnt(0);
        unsigned nloc = b.st[0], nx = b.st[1];
        if (nloc == 0u) { xcd_barrier_complete(bar, b.x, nloc, nx); b.st[0] = nloc; b.st[1] = nx; }
        const unsigned old = xb_add(&bar[XB_XSUB(b.x)], 1u);
        const unsigned gen = old / nloc;
        if (old + 1u == (gen + 1u) * nloc) {
            __builtin_amdgcn_fence(__ATOMIC_RELEASE, "agent");
            asm volatile("s_waitcnt vmcnt(0)" ::: "memory");
            const unsigned og = xb_add(&bar[XB_TOP], 1u);
            const unsigned tg = og / nx;
            if (og + 1u == (tg + 1u) * nx) xb_add(&bar[XB_TOPGEN], 1u);
            else XB_SPIN(xb_ld(&bar[XB_TOPGEN]) == tg, bar);
            __builtin_amdgcn_fence(__ATOMIC_ACQUIRE, "agent");
            xb_add(&bar[XB_XGEN(b.x)], 1u);
            asm volatile("s_waitcnt vmcnt(0)" ::: "memory");
        } else {
            XB_SPIN(xb_ld(&bar[XB_XGEN(b.x)]) == gen, bar);
            __builtin_amdgcn_fence(__ATOMIC_ACQUIRE, "agent");
            asm volatile("s_waitcnt vmcnt(0)" ::: "memory");
        }
    }
    __syncthreads();
}
typedef unsigned short bf16_t;
typedef float f32x4 __attribute__((ext_vector_type(4)));
typedef short bf16x8 __attribute__((ext_vector_type(8)));
typedef unsigned u32x4 __attribute__((ext_vector_type(4)));
#define LDS_WAIT() asm volatile("s_waitcnt lgkmcnt(0)" ::: "memory")
#define VM_WAIT() asm volatile("s_waitcnt vmcnt(0)" ::: "memory")
#define SBAR() __builtin_amdgcn_sched_barrier(0)
#define NTL(p) __builtin_nontemporal_load(p)
__device__ __forceinline__ unsigned cvtpk(float lo, float hi) { unsigned r; asm volatile("v_cvt_pk_bf16_f32 %0, %1, %2" : "=v"(r) : "v"(lo), "v"(hi)); return r; }
__device__ __forceinline__ float wave_sum(float v) {
#pragma unroll
    for (int o = 1; o < 64; o <<= 1) v += __shfl_xor(v, o);
    return v;
}
__device__ __forceinline__ int lane_id_opq() { unsigned m = ~0u; asm volatile("" : "+s"(m)); return (int)__builtin_amdgcn_mbcnt_hi(m, __builtin_amdgcn_mbcnt_lo(m, 0u)); }
__device__ __forceinline__ float silu_f(float x) { return x / (1.f + __expf(-x)); }

__device__ __forceinline__ void cvt_matrix(const float* __restrict__ W, int K, int N, bf16_t* __restrict__ WT, LAS float* scr, int gw, int NGW, int lane, int it_lo, int it_hi) {
    const int nblk = N >> 6;
    const int lr = lane >> 4, lc = (lane & 15) * 4, c8 = lane & 7, nr = lane >> 3;
    int it = it_lo + gw;
    if (it >= it_hi) return;
#define CVT_SRC(IT) (W + (size_t)(((((IT) >> 3) / nblk) * 8 + ((IT) & 7)) * 64 + lr) * N + (((IT) >> 3) % nblk) * 64 + lc)
    f32x4 v[16];
    { const float* src = CVT_SRC(it);
#pragma unroll
      for (int i = 0; i < 16; ++i) v[i] = NTL((const f32x4*)(src + (size_t)(4 * i) * N)); }
    for (;;) {
        const int grp = it >> 3, kq = grp / nblk, nb = grp - kq * nblk, kb = kq * 8 + (it & 7), k0 = kb * 64, n0 = nb * 64;
#pragma unroll
        for (int i = 0; i < 16; ++i) { LAS float* d = scr + (4 * i + lr) * 65 + lc; d[0] = v[i][0]; d[1] = v[i][1]; d[2] = v[i][2]; d[3] = v[i][3]; }
        const int nit = it + NGW; const bool more = nit < it_hi;
        if (more) { const float* src = CVT_SRC(nit);
#pragma unroll
            for (int i = 0; i < 16; ++i) v[i] = NTL((const f32x4*)(src + (size_t)(4 * i) * N)); }
        LDS_WAIT();
#pragma unroll
        for (int j0 = 0; j0 < 8; j0 += 4) {
            float t[4][8];
#pragma unroll
            for (int j = 0; j < 4; ++j) { const LAS float* s = scr + (8 * c8) * 65 + nr + 8 * (j0 + j);
#pragma unroll
                for (int e = 0; e < 8; ++e) t[j][e] = s[e * 65]; }
            LDS_WAIT();
#pragma unroll
            for (int j = 0; j < 4; ++j) { const int n = nr + 8 * (j0 + j);
                u32x4 o; o.x = cvtpk(t[j][0], t[j][1]); o.y = cvtpk(t[j][2], t[j][3]); o.z = cvtpk(t[j][4], t[j][5]); o.w = cvtpk(t[j][6], t[j][7]);
                *(u32x4*)(WT + (size_t)(n0 + n) * K + k0 + 8 * c8) = o; } }
        if (!more) break;
        it = nit;
    }
#undef CVT_SRC
}

template <bool LAST>
__device__ __forceinline__ void ln_rows(int r_lo, int r_hi, int r_st, h16_t* Xb, bf16_t* Hb, float* outb, float* statb, const LAS float* lt, int lane,
                                        const bf16_t* partb, const float* gate, float alpha, bool prev_ln, const float* pg, const float* pb) {
    if (r_lo >= r_hi) return;
    u32x4 zr[8];
#define LN_LOADROW(R_) do { const u32x4* zp_ = (const u32x4*)(Xb + (size_t)(R_) * 4096) + lane; _Pragma("unroll") for (int j = 0; j < 8; ++j) zr[j] = NTL(&zp_[64 * j]); } while (0)
    LN_LOADROW(r_lo);
    for (int row = r_lo; row < r_hi; row += r_st) {
        float v[8][8];
#pragma unroll
        for (int j = 0; j < 8; ++j) { v[j][0] = h16_lo(zr[j].x); v[j][1] = h16_hi(zr[j].x); v[j][2] = h16_lo(zr[j].y); v[j][3] = h16_hi(zr[j].y);
            v[j][4] = h16_lo(zr[j].z); v[j][5] = h16_hi(zr[j].z); v[j][6] = h16_lo(zr[j].w); v[j][7] = h16_hi(zr[j].w); }
        if (row + r_st < r_hi) LN_LOADROW(row + r_st);
        float* st = statb + 2 * row;
        if (partb != nullptr && row >= cfg::MLAT) {
            float pm = 0.f, pr = 1.f; if (prev_ln) { pm = st[0]; pr = st[1]; }
            const bf16_t* part = partb + (size_t)(row - cfg::MLAT) * 4096;
#pragma unroll
            for (int j = 0; j < 8; ++j) { const int c0 = (lane + 64 * j) * 8;
                float acc[8] = {0.f, 0.f, 0.f, 0.f, 0.f, 0.f, 0.f, 0.f};
#pragma unroll
                for (int sl = 0; sl < 8; ++sl) { const u32x4 w = NTL((const u32x4*)(part + (size_t)sl * (512 * 4096) + c0));
                    acc[0] += __uint_as_float(w.x << 16); acc[1] += __uint_as_float(w.x & 0xffff0000u); acc[2] += __uint_as_float(w.y << 16); acc[3] += __uint_as_float(w.y & 0xffff0000u);
                    acc[4] += __uint_as_float(w.z << 16); acc[5] += __uint_as_float(w.z & 0xffff0000u); acc[6] += __uint_as_float(w.w << 16); acc[7] += __uint_as_float(w.w & 0xffff0000u); }
                const f32x4 g0 = *(const f32x4*)(gate + c0), g1 = *(const f32x4*)(gate + c0 + 4);
                f32x4 a0 = {1.f, 1.f, 1.f, 1.f}, a1 = a0, b0 = {0.f, 0.f, 0.f, 0.f}, b1 = b0;
                if (prev_ln) { a0 = *(const f32x4*)(pg + c0); a1 = *(const f32x4*)(pg + c0 + 4); b0 = *(const f32x4*)(pb + c0); b1 = *(const f32x4*)(pb + c0 + 4); }
#pragma unroll
                for (int e = 0; e < 8; ++e) { const float ge = e < 4 ? g0[e & 3] : g1[e & 3], ae = e < 4 ? a0[e & 3] : a1[e & 3], be = e < 4 ? b0[e & 3] : b1[e & 3];
                    float x = v[j][e]; if (prev_ln) x = ((x - pm) * pr) * ae + be;
                    v[j][e] = x * alpha + ge * acc[e]; }
                u32x4 zo; zo.x = pk_h16(v[j][0], v[j][1]); zo.y = pk_h16(v[j][2], v[j][3]); zo.z = pk_h16(v[j][4], v[j][5]); zo.w = pk_h16(v[j][6], v[j][7]);
                *((u32x4*)(Xb + (size_t)row * 4096) + lane + 64 * j) = zo; }
        }
        float s = 0.f;
#pragma unroll
        for (int j = 0; j < 8; ++j) s += ((v[j][0] + v[j][1]) + (v[j][2] + v[j][3])) + ((v[j][4] + v[j][5]) + (v[j][6] + v[j][7]));
        const float mean = wave_sum(s) * (1.f / 4096.f); float s2 = 0.f;
#pragma unroll
        for (int j = 0; j < 8; ++j)
#pragma unroll
            for (int e = 0; e < 8; ++e) { v[j][e] -= mean; s2 += v[j][e] * v[j][e]; }
        float eps_ = cfg::LN_EPS; asm volatile("" : "+s"(eps_));
        const float rstd = __builtin_amdgcn_rsqf(wave_sum(s2) * (1.f / 4096.f) + eps_);
        if (!LAST && lane == 0) { st[0] = mean; st[1] = rstd; }
        const int cond = row < cfg::SEQ ? 0 : (row < cfg::MLAT ? 1 : 2);
        const LAS f32x4* ta = (const LAS f32x4*)(lt + (size_t)(cond * 2) * 4096) + 2 * lane; const LAS f32x4* tb = ta + 1024;
#pragma unroll
        for (int j = 0; j < 8; ++j) { const f32x4 ga0 = ta[128 * j], ga1 = ta[128 * j + 1], gb0 = tb[128 * j], gb1 = tb[128 * j + 1];
            float h[8];
#pragma unroll
            for (int e = 0; e < 8; ++e) h[e] = (v[j][e] * rstd) * (e < 4 ? ga0[e & 3] : ga1[e & 3]) + (e < 4 ? gb0[e & 3] : gb1[e & 3]);
            if (LAST) { f32x4* op = (f32x4*)(outb + (size_t)row * 4096) + 2 * (lane + 64 * j); op[0] = (f32x4){h[0], h[1], h[2], h[3]}; op[1] = (f32x4){h[4], h[5], h[6], h[7]}; }
            else { u32x4 w; w.x = cvtpk(h[0], h[1]); w.y = cvtpk(h[2], h[3]); w.z = cvtpk(h[4], h[5]); w.w = cvtpk(h[6], h[7]); *((u32x4*)(Hb + (size_t)row * 4096) + lane + 64 * j) = w; } }
    }
#undef LN_LOADROW
}
__device__ __forceinline__ void init_row(const float* srow, h16_t* xrow, bf16_t* hrow, const float* sc, const float* sh, int lane) {
#pragma unroll
    for (int j = 0; j < 16; ++j) {
        const f32x4 x = NTL(&((const f32x4*)srow)[lane + 64 * j]);
        if (xrow) { u32x2 zo_; zo_.x = pk_h16(x[0], x[1]); zo_.y = pk_h16(x[2], x[3]); ((u32x2*)xrow)[lane + 64 * j] = zo_; }
        const f32x4 scv = ((const f32x4*)sc)[lane + 64 * j], shv = ((const f32x4*)sh)[lane + 64 * j];
        const f32x4 h = x * (scv + 1.f) + shv; u32x2 w; w.x = cvtpk(h[0], h[1]); w.y = cvtpk(h[2], h[3]);
        ((u32x2*)hrow)[lane + 64 * j] = w;
    }
}
__device__ __forceinline__ void mla_norm_row(const float* drow, bf16_t* cq, bf16_t* ckv, bf16_t* kr, const float* qg, const float* kvg, const float* tab, int row, int lane) {
    f32x4 a[6], c[2]; float sa = 0.f, sc = 0.f;
#pragma unroll
    for (int j = 0; j < 6; ++j) { a[j] = NTL(&((const f32x4*)drow)[lane + 64 * j]); sa += (a[j][0] * a[j][0] + a[j][1] * a[j][1]) + (a[j][2] * a[j][2] + a[j][3] * a[j][3]); }
#pragma unroll
    for (int j = 0; j < 2; ++j) { c[j] = NTL(&((const f32x4*)(drow + 1536))[lane + 64 * j]); sc += (c[j][0] * c[j][0] + c[j][1] * c[j][1]) + (c[j][2] * c[j][2] + c[j][3] * c[j][3]); }
    float kv = drow[2048 + lane];
    const float ra = __builtin_amdgcn_rsqf(wave_sum(sa) * (1.f / 1536.f) + cfg::RMS_EPS), rc = __builtin_amdgcn_rsqf(wave_sum(sc) * (1.f / 512.f) + cfg::RMS_EPS);
#pragma unroll
    for (int j = 0; j < 6; ++j) { const f32x4 g = ((const f32x4*)qg)[lane + 64 * j]; const f32x4 y = a[j] * ra * g; u32x2 w; w.x = cvtpk(y[0], y[1]); w.y = cvtpk(y[2], y[3]); ((u32x2*)cq)[lane + 64 * j] = w; }
#pragma unroll
    for (int j = 0; j < 2; ++j) { const f32x4 g = ((const f32x4*)kvg)[lane + 64 * j]; const f32x4 y = c[j] * rc * g; u32x2 w; w.x = cvtpk(y[0], y[1]); w.y = cvtpk(y[2], y[3]); ((u32x2*)ckv)[lane + 64 * j] = w; }
    const float pv = __shfl_xor(kv, 16);
    if (row < cfg::MLAT) { const int s = row & 4095, pos = (lane & 32) ? (s & 63) : (s >> 6); const float cs = tab[pos * 16 + (lane & 15)], sn = tab[1024 + pos * 16 + (lane & 15)];
        kv = kv * cs + ((lane & 16) ? pv : -pv) * sn; }
    const float hi = __shfl_down(kv, 1);
    if ((lane & 1) == 0) ((unsigned*)kr)[lane >> 1] = cvtpk(kv, hi);
}
#ifdef PROBE_VAR
#define ATT_PROBE_SIMPLE 1
#else
#define ATT_PROBE_SIMPLE 0
#endif
#ifndef ATT_SKEW1
#define ATT_SKEW1 0
#endif
#ifndef ATT_SIMPLE2
#define ATT_SIMPLE2 1
#endif
#ifndef ATT_EXCL
#define ATT_EXCL 0
#endif
namespace att {
constexpr int LDS_RING = 0, LDS_WS = 131072, LDS_BIAS = LDS_WS + 2048, LDS_END = LDS_BIAS + 4096;
constexpr float THR2 = 8.f * 1.4426950408889634f;
__device__ __forceinline__ int lane_opq() { unsigned m = ~0u; asm volatile("" : "+s"(m)); return (int)__builtin_amdgcn_mbcnt_hi(m, __builtin_amdgcn_mbcnt_lo(m, 0u)); }
__device__ __forceinline__ int crow(int r, int hi) { return (r & 3) + 8 * (r >> 2) + 4 * hi; }
__device__ __forceinline__ int v_st(int k, int c) { const int kk = (k & ~0xC) | ((k & 4) << 1) | ((k & 8) >> 1); return ((kk >> 3) * 4 + (c >> 5)) * 512 + ((kk & 7) * 32 + (c & 31)) * 2; }
__device__ __forceinline__ int v_rd_base(int lane) { return ((lane & 3) << 3) | (((lane >> 2) & 3) << 6) | (((lane >> 4) & 1) << 5) | (((lane >> 5) & 1) << 8); }
constexpr int v_rd_off(int d0, int ks, int half) { return d0 * 512 + ks * 4096 + half * 2048; }
typedef short v4i16_t __attribute__((ext_vector_type(4)));
template <int OFF> __device__ __forceinline__ s16x4 tr_read(const LAS unsigned char* vb) {
    return __builtin_bit_cast(s16x4, __builtin_amdgcn_ds_read_tr16_b64_v4i16((LAS v4i16_t*)(vb + OFF)));
}
template <int OFF> __device__ __forceinline__ bf16x8 k_read_asm(unsigned a) {
    bf16x8 r; asm volatile("ds_read_b128 %0, %1 offset:%2" : "=v"(r) : "v"(a), "i"(OFF) : "memory"); return r;
}
template <int OFF> __device__ __forceinline__ s16x4 tr_read_asm(unsigned vb) {
    s16x4 r; asm volatile("ds_read_b64_tr_b16 %0, %1 offset:%2" : "=&v"(r) : "v"(vb), "i"(OFF) : "memory"); return r;
}
template <int D0, bool VIS> __device__ __forceinline__ void pv_one(f32x16& od, const LAS unsigned char* vb, bf16x8 pa0, bf16x8 pa1, bf16x8 pa2, bf16x8 pa3) {
    s16x4 l0, h0, l1, h1, l2, h2, l3, h3;
    if constexpr (VIS) {
        l0 = tr_read<v_rd_off(D0, 0, 0)>(vb); h0 = tr_read<v_rd_off(D0, 0, 1)>(vb); l1 = tr_read<v_rd_off(D0, 1, 0)>(vb); h1 = tr_read<v_rd_off(D0, 1, 1)>(vb);
        l2 = tr_read<v_rd_off(D0, 2, 0)>(vb); h2 = tr_read<v_rd_off(D0, 2, 1)>(vb); l3 = tr_read<v_rd_off(D0, 3, 0)>(vb); h3 = tr_read<v_rd_off(D0, 3, 1)>(vb);
    } else {
        const unsigned vu = (unsigned)(uintptr_t)vb;
        l0 = tr_read_asm<v_rd_off(D0, 0, 0)>(vu); h0 = tr_read_asm<v_rd_off(D0, 0, 1)>(vu); l1 = tr_read_asm<v_rd_off(D0, 1, 0)>(vu); h1 = tr_read_asm<v_rd_off(D0, 1, 1)>(vu);
        l2 = tr_read_asm<v_rd_off(D0, 2, 0)>(vu); h2 = tr_read_asm<v_rd_off(D0, 2, 1)>(vu); l3 = tr_read_asm<v_rd_off(D0, 3, 0)>(vu); h3 = tr_read_asm<v_rd_off(D0, 3, 1)>(vu);
        asm volatile("s_waitcnt lgkmcnt(0)" ::: "memory"); SBAR();
    }
#define ATT_PK(L, H) (bf16x8){L[0], L[1], L[2], L[3], H[0], H[1], H[2], H[3]}
    od = __builtin_amdgcn_mfma_f32_32x32x16_bf16(pa0, ATT_PK(l0, h0), od, 0, 0, 0);
    od = __builtin_amdgcn_mfma_f32_32x32x16_bf16(pa1, ATT_PK(l1, h1), od, 0, 0, 0);
    od = __builtin_amdgcn_mfma_f32_32x32x16_bf16(pa2, ATT_PK(l2, h2), od, 0, 0, 0);
    od = __builtin_amdgcn_mfma_f32_32x32x16_bf16(pa3, ATT_PK(l3, h3), od, 0, 0, 0);
#undef ATT_PK
}
template <int DQK> __device__ __forceinline__ int kswg(int row) { return DQK == 128 ? (row & 15) : ((row >> 1) & 7); }
template <int DQK> __device__ __forceinline__ int kswz(int row, int colB) { return row * (DQK * 2) + (colB ^ (kswg<DQK>(row) << 4)); }

struct Src {
    const bf16_t* Q; int ldq;
    const bf16_t* K1; int ldk1;
    const bf16_t* K2; int ldk2;
    const bf16_t* V; int ldv;
    int ctx_row0, lat_row0;
    int NT;
};
template <int DQK, int MODE>
__device__ __forceinline__ void attn_core(const Src& S, float C  , LAS unsigned char* lds, f32x16 (&o)[4], float& l_reg, const int wave_id_, const int var_  ,
                                          int na_r  , int na_krlo, int na_c  ) {
    constexpr int NQ = DQK / 16, KCH = DQK / 8, KPT = KCH / 8  , KBUF = 64 * DQK * 2;
    constexpr int NS = (DQK == 192) ? 3 : 4, SS = 16384 + KBUF, IPT = 2 + KPT;
    static_assert(NS * SS <= LDS_WS, "attention ring");
    int wave_id = wave_id_; asm volatile("" : "+s"(wave_id));
    int lane = lane_opq(); asm volatile("" : "+v"(lane));
    float NEGBIG = -1e30f; asm volatile("" : "+s"(NEGBIG));
    const int wid = wave_id, r32 = lane & 31, hi = lane >> 5;
    LAS unsigned char* ring = lds + LDS_RING;
    LAS float* wsf = (LAS float*)(lds + LDS_WS) + wid * 64; LAS float* al_l = wsf + 32;
    float m_reg = NEGBIG; l_reg = 0.f;
#pragma unroll
    for (int d = 0; d < 4; ++d)
#pragma unroll
        for (int r = 0; r < 16; ++r) o[d][r] = 0.f;
    bf16x8 qr[NQ];
    { const bf16_t* Qw = S.Q + (size_t)(wid * 32 + r32) * S.ldq + hi * 8;
#pragma unroll
      for (int d0 = 0; d0 < NQ; ++d0) qr[d0] = *(const bf16x8*)(Qw + d0 * 16); }
    int voffV[2]; int koff[KPT]; bool k2[KPT];
#pragma unroll
    for (int i = 0; i < 2; ++i) { const int q = i * 512 + wid * 64 + lane, sub = q >> 5, within = q & 31, kk = (sub >> 2) * 8 + (within >> 2), c = (sub & 3) * 32 + (within & 3) * 8;
        const int k = ATT_SIMPLE2 ? kk : ((kk & ~0xC) | ((kk & 4) << 1) | ((kk & 8) >> 1)); voffV[i] = k * S.ldv + c; }
#pragma unroll
    for (int i = 0; i < KPT; ++i) { const int q = i * 512 + wid * 64 + lane, row = q / KCH, cpos = q - row * KCH, col = (cpos ^ kswg<DQK>(row)) * 8;
        k2[i] = (DQK == 192) && col >= 128; koff[i] = k2[i] ? row * S.ldk2 + (col - 128) : row * S.ldk1 + col; }
    const LAS unsigned char* vb0 = ring + v_rd_base(lane);
    constexpr int NKB = (DQK == 128) ? 8 : 4;
    int kb4[NKB];
#pragma unroll
    for (int i = 0; i < NKB; ++i) kb4[i] = kswz<DQK>(r32, (i * 16 + hi * 8) * 2);
#define ATT_ROW0(j) ((j) < 4 ? S.ctx_row0 + 64 * (j) : S.lat_row0 + 64 * ((j) - 4))
#define ATT_ISSUE(T) do { const int _r0 = ATT_ROW0(T); LAS unsigned char* _st = ring + ((T) % NS) * SS + wid * 1024; \
        const bf16_t* _vb = S.V + (size_t)_r0 * S.ldv; const bf16_t* _k1 = S.K1 + (size_t)_r0 * S.ldk1; const bf16_t* _k2 = (DQK == 192) ? S.K2 + (size_t)_r0 * S.ldk2 : _k1; \
        _Pragma("unroll") for (int _i = 0; _i < 2; ++_i) __builtin_amdgcn_global_load_lds((const unsigned*)(_vb + voffV[_i]), (LAS unsigned*)(_st + _i * 8192), 16, 0, 0); \
        _Pragma("unroll") for (int _i = 0; _i < KPT; ++_i) __builtin_amdgcn_global_load_lds((const unsigned*)((k2[_i] ? _k2 : _k1) + koff[_i]), (LAS unsigned*)(_st + 16384 + _i * 8192), 16, 0, 0); } while (0)
#define ATT_VMWAIT(N) asm volatile("s_waitcnt vmcnt(%0)" :: "n"(N) : "memory")
#define ATT_BAR() asm volatile("s_waitcnt lgkmcnt(0)\n\ts_barrier" ::: "memory")
#define ATT_SG(mask, n, id) __builtin_amdgcn_sched_group_barrier(mask, n, id)
    const int NT = S.NT;
#define ATT_ACTIVE(j) true
    int na_r0 = na_r - 4; na_r0 = na_r0 < 0 ? 0 : (na_r0 > 56 ? 56 : na_r0);
    int na_cs = na_c - 8; na_cs = na_cs < 0 ? 0 : (na_cs > 48 ? 48 : na_cs);
#define ATT_QKT(P0, P1, j) do { const LAS unsigned char* Kb = ring + ((j) % NS) * SS + 16384; \
        _Pragma("unroll") for (int r = 0; r < 16; ++r) { P0[r] = 0.f; P1[r] = 0.f; } \
        _Pragma("unroll") for (int d0 = 0; d0 < NQ; ++d0) { const LAS unsigned char* kp = Kb + kb4[d0 % NKB] + (d0 / NKB) * (NKB * 32); \
            const bf16x8 k0 = *(const LAS bf16x8*)kp, k1 = *(const LAS bf16x8*)(kp + 32 * DQK * 2); \
            P0 = __builtin_amdgcn_mfma_f32_32x32x16_bf16(k0, qr[d0], P0, 0, 0, 0); \
            P1 = __builtin_amdgcn_mfma_f32_32x32x16_bf16(k1, qr[d0], P1, 0, 0, 0); \
            if (NQ > 8 && (d0 & 3) == 3 && d0 + 1 < NQ) SBAR(); } } while (0)
#define ATT_PART_A(P0, P1, j) do { \
        if (MODE == 1 && (j) >= 4) { const int kr = na_krlo + (j) - 4; const int cs_eff = (kr >= na_r0 && kr < na_r0 + 8) ? na_cs : 64; \
            const LAS float* bt = (const LAS float*)(lds + LDS_BIAS) + 64 + (kr - na_r + 7) * 32 + (15 - na_c) + 4 * hi; \
            _Pragma("unroll") for (int r = 0; r < 16; ++r) { const int kc0 = (r & 3) + 8 * (r >> 2); \
                const float b0 = bt[kc0], b1 = bt[kc0 + 32]; const int k0c = kc0 + 4 * hi - cs_eff, k1c = k0c + 32; \
                P0[r] = ((unsigned)k0c < 16u) ? fmaf(P0[r], C, b0) : NEGBIG; P1[r] = ((unsigned)k1c < 16u) ? fmaf(P1[r], C, b1) : NEGBIG; } } \
        pmax_ = fmaxf(P0[0], P1[0]); \
        _Pragma("unroll") for (int r = 1; r < 16; ++r) pmax_ = fmaxf(fmaxf(pmax_, P0[r]), P1[r]); \
        { auto rr = __builtin_amdgcn_permlane32_swap(__float_as_uint(pmax_), __float_as_uint(pmax_), false, false); pmax_ = fmaxf(__uint_as_float(rr[0]), __uint_as_float(rr[1])); } } while (0)
#define ATT_PART_B(P0, P1, AL, j) do { \
        const float CC = (MODE == 1 && (j) >= 4) ? 1.f : C; pmax_ *= CC; \
        { const bool keep_ = __all(pmax_ - m_reg <= THR2); const float mn = keep_ ? m_reg : fmaxf(m_reg, pmax_); AL = __builtin_amdgcn_exp2f(m_reg - mn); m_reg = mn; }     \
        const float nm = -m_reg; \
        _Pragma("unroll") for (int r = 0; r < 16; ++r) P0[r] = __builtin_amdgcn_exp2f(fmaf(P0[r], CC, nm)); } while (0)
#define ATT_PART_C(P0, P1, j) do { \
        const float CC = (MODE == 1 && (j) >= 4) ? 1.f : C; const float nm = -m_reg; \
        _Pragma("unroll") for (int r = 0; r < 16; ++r) { P1[r] = fmaf(P1[r], CC, nm); if (EXP_EARLY) P1[r] = __builtin_amdgcn_exp2f(P1[r]); } } while (0)
#define ATT_PARTIAL(P0, P1, AL, j) do { ATT_PART_A(P0, P1, j); ATT_PART_B(P0, P1, AL, j); ATT_PART_C(P0, P1, j); } while (0)
#define ATT_PK4(P, BASE, OUT) do { unsigned a0 = cvtpk(P[BASE + 0], P[BASE + 1]), a1 = cvtpk(P[BASE + 2], P[BASE + 3]); \
        unsigned b0 = cvtpk(P[BASE + 4], P[BASE + 5]), b1 = cvtpk(P[BASE + 6], P[BASE + 7]); \
        auto r0 = __builtin_amdgcn_permlane32_swap(a0, b0, false, false); auto r1 = __builtin_amdgcn_permlane32_swap(a1, b1, false, false); \
        u32x4 w = {r0[0], r1[0], r0[1], r1[1]}; OUT = *reinterpret_cast<bf16x8*>(&w); } while (0)
#define ATT_FINISH(P0, P1, AL) do { float ps = 0.f; \
        _Pragma("unroll") for (int r = 0; r < 16; ++r) { if (!EXP_EARLY) P1[r] = __builtin_amdgcn_exp2f(P1[r]); ps += P0[r] + P1[r]; } \
        { auto rr = __builtin_amdgcn_permlane32_swap(__float_as_uint(ps), __float_as_uint(ps), false, false); ps = __uint_as_float(rr[0]) + __uint_as_float(rr[1]); } \
        l_reg = l_reg * AL + ps; \
        ATT_PK4(P0, 0, pa0); ATT_PK4(P0, 8, pa1); ATT_PK4(P1, 0, pa2); ATT_PK4(P1, 8, pa3); } while (0)
#define ATT_RESC(AL) do { if (__any((AL) < 1.f)) { if (hi == 0) al_l[r32] = (AL); LDS_WAIT(); \
        _Pragma("unroll") for (int r = 0; r < 16; ++r) { const float a_ = al_l[crow(r, hi)]; _Pragma("unroll") for (int d = 0; d < 4; ++d) o[d][r] *= a_; } } } while (0)
#define ATT_PV1(j, D0) do { const LAS unsigned char* vb = vb0 + ((j) % NS) * SS; pv_one<D0, (!ATT_SKEW1 && !ATT_PROBE_SIMPLE && DQK == 64)>(o[D0], vb, pa0, pa1, pa2, pa3); } while (0)
#define ATT_TRR(k) do { constexpr int d0_ = ((k) >> 2), ks_ = ((k) & 3); trl[(k) % 3] = tr_read_asm<v_rd_off(d0_, ks_, 0)>(vbu_); trh[(k) % 3] = tr_read_asm<v_rd_off(d0_, ks_, 1)>(vbu_); } while (0)
#define ATT_MM(k) do { const s16x4 L_ = trl[(k) % 3], H_ = trh[(k) % 3]; const bf16x8 vf_ = (bf16x8){L_[0], L_[1], L_[2], L_[3], H_[0], H_[1], H_[2], H_[3]}; \
        o[(k) >> 2] = __builtin_amdgcn_mfma_f32_32x32x16_bf16(((k) & 3) == 0 ? pa0 : ((k) & 3) == 1 ? pa1 : ((k) & 3) == 2 ? pa2 : pa3, vf_, o[(k) >> 2], 0, 0, 0); } while (0)
#define ATT_MAX2(P0, P1, r) do { pmax_ = fmaxf(fmaxf(pmax_, P0[r]), P1[r]); pmax_ = fmaxf(fmaxf(pmax_, P0[(r) + 1]), P1[(r) + 1]); } while (0)
#define ATT_EXPR(P0, P1, r) do { P0[r] = __builtin_amdgcn_exp2f(fmaf(P0[r], C, nm_)); P1[r] = __builtin_amdgcn_exp2f(fmaf(P1[r], C, nm_)); } while (0)
#define ATT_CHUNK(k, WAITN, VALU_CODE) do { if ((k) + 2 < 16) ATT_TRR((k) + 2); asm volatile("s_waitcnt lgkmcnt(" #WAITN ")" ::: "memory"); SBAR(); ATT_MM(k); VALU_CODE; SBAR(); } while (0)
#define ATT_PVX(j, P0, P1, AL, HASN_) do { const unsigned vbu_ = (unsigned)(uintptr_t)(vb0 + ((j) % NS) * SS); s16x4 trl[3], trh[3]; float nm_ = 0.f; \
        ATT_TRR(0); ATT_TRR(1); \
        if (HASN_) pmax_ = fmaxf(P0[0], P1[0]); \
        ATT_CHUNK(0, 4, if (HASN_) { pmax_ = fmaxf(fmaxf(pmax_, P0[1]), P1[1]); }); \
        ATT_CHUNK(1, 4, if (HASN_) ATT_MAX2(P0, P1, 2)); ATT_CHUNK(2, 4, if (HASN_) ATT_MAX2(P0, P1, 4)); ATT_CHUNK(3, 4, if (HASN_) ATT_MAX2(P0, P1, 6)); \
        ATT_CHUNK(4, 4, if (HASN_) ATT_MAX2(P0, P1, 8)); ATT_CHUNK(5, 4, if (HASN_) ATT_MAX2(P0, P1, 10)); ATT_CHUNK(6, 4, if (HASN_) ATT_MAX2(P0, P1, 12)); ATT_CHUNK(7, 4, if (HASN_) ATT_MAX2(P0, P1, 14)); \
        ATT_CHUNK(8, 4, if (HASN_) { auto rr = __builtin_amdgcn_permlane32_swap(__float_as_uint(pmax_), __float_as_uint(pmax_), false, false); pmax_ = fmaxf(__uint_as_float(rr[0]), __uint_as_float(rr[1])) * C; \
            const bool keep_ = __all(pmax_ - m_reg <= THR2); const float mn = keep_ ? m_reg : fmaxf(m_reg, pmax_); AL = __builtin_amdgcn_exp2f(m_reg - mn); m_reg = mn; nm_ = -mn; }); \
        ATT_CHUNK(9, 4, if (HASN_) { ATT_EXPR(P0, P1, 0); ATT_EXPR(P0, P1, 1); ATT_EXPR(P0, P1, 2); }); \
        ATT_CHUNK(10, 4, if (HASN_) { ATT_EXPR(P0, P1, 3); ATT_EXPR(P0, P1, 4); }); ATT_CHUNK(11, 4, if (HASN_) { ATT_EXPR(P0, P1, 5); ATT_EXPR(P0, P1, 6); }); \
        ATT_CHUNK(12, 4, if (HASN_) { ATT_EXPR(P0, P1, 7); ATT_EXPR(P0, P1, 8); }); ATT_CHUNK(13, 4, if (HASN_) { ATT_EXPR(P0, P1, 9); ATT_EXPR(P0, P1, 10); }); \
        ATT_CHUNK(14, 2, if (HASN_) { ATT_EXPR(P0, P1, 11); ATT_EXPR(P0, P1, 12); }); ATT_CHUNK(15, 0, if (HASN_) { ATT_EXPR(P0, P1, 13); ATT_EXPR(P0, P1, 14); ATT_EXPR(P0, P1, 15); }); \
    } while (0)
#define ATT_STEP(PC0, PC1, ALC, PN0, PN1, ALN, j, HASN) do { \
        if (!(var_ & 16)) ATT_BAR(); \
        if (!(var_ & 8)) { if ((j) + NS - 1 < NT) ATT_ISSUE((j) + NS - 1); } \
        const bool actC = ATT_ACTIVE(j), actN = HASN && ATT_ACTIVE((j) + 1); \
        SBAR(); if (actN && !(var_ & 4)) ATT_QKT(PN0, PN1, (j) + 1); \
        if (actC && !(var_ & 1)) ATT_FINISH(PC0, PC1, ALC); \
        if (DQK == 64 && !ATT_PROBE_SIMPLE) { ATT_SG(0x100, 4, 0); _Pragma("unroll") for (int g_ = 0; g_ < 2 * NQ; ++g_) { ATT_SG(0x008, 1, 0); ATT_SG(0x100, 1, 0); ATT_SG(0x002, 8, 0); } } \
        SBAR(); \
        if (DQK == 64 && !ATT_PROBE_SIMPLE) { \
            ATT_PVX(j, PN0, PN1, ALN, HASN); \
        } else { \
            if (actC && !(var_ & 2)) { ATT_PV1(j, 0); ATT_PV1(j, 1); ATT_PV1(j, 2); ATT_PV1(j, 3); } \
            if (actN && !(var_ & 1)) ATT_PARTIAL(PN0, PN1, ALN, (j) + 1); \
        } \
        if (actN && !(var_ & 1)) ATT_RESC(ALN); \
        if (!(var_ & 8)) { if ((j) + 2 < NT) { if ((j) + NS - 1 < NT) ATT_VMWAIT((NS - 3) * IPT); else ATT_VMWAIT(0); } } \
    } while (0)
#if ATT_SIMPLE2
    if constexpr (ATT_EXCL && DQK == 64 && MODE == 0) {
    const bool trail = wid >= 4;
    __syncthreads();
#pragma unroll
    for (int t = 0; t < 3; ++t) if (t < NT) ATT_ISSUE(t);
    if (NT >= 3) ATT_VMWAIT(2 * IPT); else ATT_VMWAIT(0);
    f32x16 negm, pA0, pA1, pB0, pB1; bf16x8 pa0, pa1, pa2, pa3; float psC = 0.f, psN = 0.f;
#pragma unroll
    for (int r = 0; r < 16; ++r) negm[r] = 0.f;
    float lim_ = 16384.f; asm volatile("" : "+s"(lim_));
    ATT_BAR();
#define EX_QK(P0, P1, T) do { const LAS unsigned char* Kb = ring + ((T) & 3) * SS + 16384; \
        _Pragma("unroll") for (int d0 = 0; d0 < NQ; ++d0) { const LAS unsigned char* kp = Kb + kb4[d0 % NKB] + (d0 / NKB) * (NKB * 32); \
            const bf16x8 k0 = *(const LAS bf16x8*)kp, k1 = *(const LAS bf16x8*)(kp + 32 * DQK * 2); \
            if (d0 == 0) { P0 = __builtin_amdgcn_mfma_f32_32x32x16_bf16(k0, qr[0], negm, 0, 0, 0); P1 = __builtin_amdgcn_mfma_f32_32x32x16_bf16(k1, qr[0], negm, 0, 0, 0); } \
            else { P0 = __builtin_amdgcn_mfma_f32_32x32x16_bf16(k0, qr[d0], P0, 0, 0, 0); P1 = __builtin_amdgcn_mfma_f32_32x32x16_bf16(k1, qr[d0], P1, 0, 0, 0); } } } while (0)
#define EX_PKD(P, BASE, OUT) do { u32x4 w = {cvtpk(P[BASE + 0], P[BASE + 1]), cvtpk(P[BASE + 2], P[BASE + 3]), cvtpk(P[BASE + 4], P[BASE + 5]), cvtpk(P[BASE + 6], P[BASE + 7])}; OUT = *reinterpret_cast<bf16x8*>(&w); } while (0)
#define EX_SLOW(P0, P1, PS) do { if (__any(PS > lim_)) { const float d_ = PS > lim_ ? __builtin_amdgcn_logf(PS) : 0.f; const float al = __builtin_amdgcn_exp2f(-d_); \
        m_reg += d_; PS *= al; l_reg *= al; \
        _Pragma("unroll") for (int r = 0; r < 16; ++r) { P0[r] *= al; P1[r] *= al; negm[r] -= d_; } \
        if (hi == 0) al_l[r32] = al; LDS_WAIT(); \
        _Pragma("unroll") for (int r = 0; r < 16; ++r) { const float a_ = al_l[crow(r, hi)]; _Pragma("unroll") for (int d = 0; d < 4; ++d) o[d][r] *= a_; } } } while (0)
    {
        EX_QK(pA0, pA1, 0);
        float pmax = fmaxf(pA0[0], pA1[0]);
#pragma unroll
        for (int r = 1; r < 16; ++r) pmax = fmaxf(fmaxf(pmax, pA0[r]), pA1[r]);
        { auto rr = __builtin_amdgcn_permlane32_swap(__float_as_uint(pmax), __float_as_uint(pmax), false, false); pmax = fmaxf(__uint_as_float(rr[0]), __uint_as_float(rr[1])); }
        m_reg = pmax;
#pragma unroll
        for (int r = 0; r < 16; ++r) { negm[r] = -pmax; pA0[r] = __builtin_amdgcn_exp2f(pA0[r] - pmax); pA1[r] = __builtin_amdgcn_exp2f(pA1[r] - pmax); psC += pA0[r] + pA1[r]; }
        { auto rr = __builtin_amdgcn_permlane32_swap(__float_as_uint(psC), __float_as_uint(psC), false, false); psC = __uint_as_float(rr[0]) + __uint_as_float(rr[1]); }
    }
    if (NT >= 2) { if (NT >= 3) ATT_VMWAIT(IPT); else ATT_VMWAIT(0); }
    if (trail) ATT_BAR();
#define EX_PIECE(P0, P1, k, HASN_) do { if (HASN_) { P0[k] = __builtin_amdgcn_exp2f(P0[k]); P1[k] = __builtin_amdgcn_exp2f(P1[k]); psN += P0[k] + P1[k]; } } while (0)
#define EX_STEP(PC0, PC1, PN0, PN1, s, HASN_) do { \
        ATT_BAR();                                       \
        if ((s) + 3 < NT) ATT_ISSUE((s) + 3); \
        SBAR(); \
        if (HASN_) EX_QK(PN0, PN1, (s) + 1); \
        l_reg += psC; EX_PKD(PC0, 0, pa0); EX_PKD(PC0, 8, pa1); EX_PKD(PC1, 0, pa2); EX_PKD(PC1, 8, pa3); \
        SBAR(); \
        { const unsigned vbu_ = (unsigned)(uintptr_t)(vb0 + ((s) & 3) * SS); s16x4 trl[3], trh[3]; psN = 0.f; \
          ATT_TRR(0); ATT_TRR(1); \
          ATT_CHUNK(0, 4, EX_PIECE(PN0, PN1, 0, HASN_)); ATT_CHUNK(1, 4, EX_PIECE(PN0, PN1, 1, HASN_)); ATT_CHUNK(2, 4, EX_PIECE(PN0, PN1, 2, HASN_)); ATT_CHUNK(3, 4, EX_PIECE(PN0, PN1, 3, HASN_)); \
          ATT_CHUNK(4, 4, EX_PIECE(PN0, PN1, 4, HASN_)); ATT_CHUNK(5, 4, EX_PIECE(PN0, PN1, 5, HASN_)); ATT_CHUNK(6, 4, EX_PIECE(PN0, PN1, 6, HASN_)); ATT_CHUNK(7, 4, EX_PIECE(PN0, PN1, 7, HASN_)); \
          ATT_CHUNK(8, 4, EX_PIECE(PN0, PN1, 8, HASN_)); ATT_CHUNK(9, 4, EX_PIECE(PN0, PN1, 9, HASN_)); ATT_CHUNK(10, 4, EX_PIECE(PN0, PN1, 10, HASN_)); ATT_CHUNK(11, 4, EX_PIECE(PN0, PN1, 11, HASN_)); \
          ATT_CHUNK(12, 4, EX_PIECE(PN0, PN1, 12, HASN_)); ATT_CHUNK(13, 4, EX_PIECE(PN0, PN1, 13, HASN_)); ATT_CHUNK(14, 2, EX_PIECE(PN0, PN1, 14, HASN_)); ATT_CHUNK(15, 0, EX_PIECE(PN0, PN1, 15, HASN_)); } \
        if (HASN_) { { auto rr = __builtin_amdgcn_permlane32_swap(__float_as_uint(psN), __float_as_uint(psN), false, false); psN = __uint_as_float(rr[0]) + __uint_as_float(rr[1]); } \
            EX_SLOW(PN0, PN1, psN); psC = psN; } \
        if ((s) + 2 < NT) { if ((s) + 3 < NT) ATT_VMWAIT(IPT); else ATT_VMWAIT(0); } \
        ATT_BAR();                                       \
    } while (0)
    int s = 0;
#pragma unroll 1
    for (; s + 1 < NT; s += 2) { EX_STEP(pA0, pA1, pB0, pB1, s, true); EX_STEP(pB0, pB1, pA0, pA1, s + 1, ((s) + 2 < NT)); }
    if (s < NT) { EX_STEP(pA0, pA1, pB0, pB1, s, false); }
    if (!trail) ATT_BAR();
#undef EX_QK
#undef EX_PKD
#undef EX_SLOW
#undef EX_PIECE
#undef EX_STEP
    } else {
    __syncthreads();
#pragma unroll
    for (int t = 0; t < NS - 1; ++t) if (t < NT) ATT_ISSUE(t);
    if (NT >= NS - 1) ATT_VMWAIT((NS - 2) * IPT); else ATT_VMWAIT(0);
    f32x16 negm; bf16x8 pa0, pa1, pa2, pa3;
#pragma unroll
    for (int r = 0; r < 16; ++r) negm[r] = 0.f;
    float lim_ = 16384.f; asm volatile("" : "+s"(lim_));
    for (int j = 0; j < NT; ++j) {
        ATT_BAR();
        if (j + NS - 1 < NT) ATT_ISSUE(j + NS - 1);
        bool act_ = true;
        if (MODE == 1 && j >= 4) { const int kr = na_krlo + j - 4; act_ = (kr >= na_r0) && (kr < na_r0 + 8); }
        if (act_) {
        f32x16 p0, p1;
        float ps_early = 0.f; bool p0_done = false;
        if (MODE == 0 && j > 0) {
            const unsigned kbu = (unsigned)(uintptr_t)(ring + (j % NS) * SS + 16384);
            constexpr int NS2 = 2 * NQ, KA = 4, RPS = (16 + NQ - 1) / NQ;
            bf16x8 kq[KA + 1];
#define ATT_KRD1(S_) do { const int d_ = (S_) % NQ; const unsigned ka_ = kbu + (unsigned)(kb4[d_ % NKB] + (d_ / NKB) * (NKB * 32)); \
                if ((S_) < NQ) kq[(S_) % (KA + 1)] = k_read_asm<0>(ka_); else kq[(S_) % (KA + 1)] = k_read_asm<32 * DQK * 2>(ka_); } while (0)
#pragma unroll
            for (int s = 0; s < KA; ++s) ATT_KRD1(s);
#pragma unroll
            for (int s = 0; s < NS2; ++s) {
                if (s + KA < NS2) ATT_KRD1(s + KA);
                const int after = (NS2 - 1 - s) < KA ? (NS2 - 1 - s) : KA;
                if (after >= 4) asm volatile("s_waitcnt lgkmcnt(4)" ::: "memory"); else if (after == 3) asm volatile("s_waitcnt lgkmcnt(3)" ::: "memory");
                else if (after == 2) asm volatile("s_waitcnt lgkmcnt(2)" ::: "memory"); else if (after == 1) asm volatile("s_waitcnt lgkmcnt(1)" ::: "memory"); else asm volatile("s_waitcnt lgkmcnt(0)" ::: "memory");
                SBAR();
                const bf16x8 kk = kq[s % (KA + 1)]; const int d0 = s % NQ;
                if (s < NQ) { if (d0 == 0) p0 = __builtin_amdgcn_mfma_f32_32x32x16_bf16(kk, qr[0], negm, 0, 0, 0); else p0 = __builtin_amdgcn_mfma_f32_32x32x16_bf16(kk, qr[d0], p0, 0, 0, 0); }
                else { if (d0 == 0) p1 = __builtin_amdgcn_mfma_f32_32x32x16_bf16(kk, qr[0], negm, 0, 0, 0); else p1 = __builtin_amdgcn_mfma_f32_32x32x16_bf16(kk, qr[d0], p1, 0, 0, 0);
#pragma unroll
                    for (int rr_ = 0; rr_ < RPS; ++rr_) { const int r = d0 * RPS + rr_; if (r < 16) { p0[r] = __builtin_amdgcn_exp2f(p0[r]); ps_early += p0[r]; } } }
                SBAR(); }
#undef ATT_KRD1
            p0_done = true;
        } else
        {
            constexpr int KD = 2;
            const unsigned kbu = (unsigned)(uintptr_t)(ring + (j % NS) * SS + 16384);
            bf16x8 kf[KD + 1][2];
#define ATT_KRD(D_) do { const unsigned ka_ = kbu + (unsigned)(kb4[(D_) % NKB] + ((D_) / NKB) * (NKB * 32)); kf[(D_) % (KD + 1)][0] = k_read_asm<0>(ka_); kf[(D_) % (KD + 1)][1] = k_read_asm<32 * DQK * 2>(ka_); } while (0)
#pragma unroll
            for (int d0 = 0; d0 < KD; ++d0) if (d0 < NQ) ATT_KRD(d0);
#pragma unroll
            for (int d0 = 0; d0 < NQ; ++d0) {
                if (d0 + KD < NQ) ATT_KRD(d0 + KD);
                const int after = (NQ - 1 - d0) < KD ? (NQ - 1 - d0) : KD;
                if (after >= 2) asm volatile("s_waitcnt lgkmcnt(4)" ::: "memory"); else if (after == 1) asm volatile("s_waitcnt lgkmcnt(2)" ::: "memory"); else asm volatile("s_waitcnt lgkmcnt(0)" ::: "memory");
                SBAR();
                const bf16x8 k0 = kf[d0 % (KD + 1)][0], k1 = kf[d0 % (KD + 1)][1];
                if (d0 == 0) { p0 = __builtin_amdgcn_mfma_f32_32x32x16_bf16(k0, qr[0], negm, 0, 0, 0); p1 = __builtin_amdgcn_mfma_f32_32x32x16_bf16(k1, qr[0], negm, 0, 0, 0); }
                else { p0 = __builtin_amdgcn_mfma_f32_32x32x16_bf16(k0, qr[d0], p0, 0, 0, 0); p1 = __builtin_amdgcn_mfma_f32_32x32x16_bf16(k1, qr[d0], p1, 0, 0, 0); }
                SBAR(); }
#undef ATT_KRD
        }
        if (MODE == 1 && j >= 4) { const int kr = na_krlo + j - 4; const int cs_eff = na_cs;
            const LAS float* bt = (const LAS float*)(lds + LDS_BIAS) + 64 + (kr - na_r + 7) * 32 + (15 - na_c) + 4 * hi;
#pragma unroll
            for (int r = 0; r < 16; ++r) { const int kc0 = (r & 3) + 8 * (r >> 2);
                const float b0 = bt[kc0], b1 = bt[kc0 + 32]; const int k0c = kc0 + 4 * hi - cs_eff, k1c = k0c + 32;
                p0[r] = ((unsigned)k0c < 16u) ? p0[r] + b0 : NEGBIG; p1[r] = ((unsigned)k1c < 16u) ? p1[r] + b1 : NEGBIG; } }
        if (j == 0) {
            float pmax = fmaxf(p0[0], p1[0]);
#pragma unroll
            for (int r = 1; r < 16; ++r) pmax = fmaxf(fmaxf(pmax, p0[r]), p1[r]);
            { auto rr = __builtin_amdgcn_permlane32_swap(__float_as_uint(pmax), __float_as_uint(pmax), false, false); pmax = fmaxf(__uint_as_float(rr[0]), __uint_as_float(rr[1])); }
            m_reg = pmax;
#pragma unroll
            for (int r = 0; r < 16; ++r) { p0[r] -= pmax; p1[r] -= pmax; negm[r] = -pmax; }
        }
        float ps = ps_early;
        if (p0_done) {
#pragma unroll
            for (int r = 0; r < 16; ++r) { p1[r] = __builtin_amdgcn_exp2f(p1[r]); ps += p1[r]; }
        } else {
#pragma unroll
            for (int r = 0; r < 16; ++r) { p0[r] = __builtin_amdgcn_exp2f(p0[r]); p1[r] = __builtin_amdgcn_exp2f(p1[r]); ps += p0[r] + p1[r]; }
        }
        { auto rr = __builtin_amdgcn_permlane32_swap(__float_as_uint(ps), __float_as_uint(ps), false, false); ps = __uint_as_float(rr[0]) + __uint_as_float(rr[1]); }
        if (__any(ps > lim_)) {
            const float d_ = ps > lim_ ? __builtin_amdgcn_logf(ps) : 0.f;
            const float al = __builtin_amdgcn_exp2f(-d_);
            m_reg += d_; ps *= al; l_reg *= al;
#pragma unroll
            for (int r = 0; r < 16; ++r) { p0[r] *= al; p1[r] *= al; negm[r] -= d_; }
            if (hi == 0) al_l[r32] = al; LDS_WAIT();
#pragma unroll
            for (int r = 0; r < 16; ++r) { const float a_ = al_l[crow(r, hi)];
#pragma unroll
                for (int d = 0; d < 4; ++d) o[d][r] *= a_; }
        }
        l_reg += ps;
#define ATT_PKD(P, BASE, OUT) do { u32x4 w = {cvtpk(P[BASE + 0], P[BASE + 1]), cvtpk(P[BASE + 2], P[BASE + 3]), cvtpk(P[BASE + 4], P[BASE + 5]), cvtpk(P[BASE + 6], P[BASE + 7])}; OUT = *reinterpret_cast<bf16x8*>(&w); } while (0)
        ATT_PKD(p0, 0, pa0); ATT_PKD(p0, 8, pa1); ATT_PKD(p1, 0, pa2); ATT_PKD(p1, 8, pa3);
#undef ATT_PKD
        {
            const unsigned vu = (unsigned)(uintptr_t)(vb0 + (j % NS) * SS);
            s16x4 fl[2][4], fh[2][4];
#define ATT_VRD(B, S_) do { fl[S_][0] = tr_read_asm<v_rd_off(B, 0, 0)>(vu); fh[S_][0] = tr_read_asm<v_rd_off(B, 0, 1)>(vu); fl[S_][1] = tr_read_asm<v_rd_off(B, 1, 0)>(vu); fh[S_][1] = tr_read_asm<v_rd_off(B, 1, 1)>(vu); \
                fl[S_][2] = tr_read_asm<v_rd_off(B, 2, 0)>(vu); fh[S_][2] = tr_read_asm<v_rd_off(B, 2, 1)>(vu); fl[S_][3] = tr_read_asm<v_rd_off(B, 3, 0)>(vu); fh[S_][3] = tr_read_asm<v_rd_off(B, 3, 1)>(vu); } while (0)
#define ATT_VMM(B, S_) do { \
                o[B] = __builtin_amdgcn_mfma_f32_32x32x16_bf16(pa0, (bf16x8){fl[S_][0][0], fl[S_][0][1], fl[S_][0][2], fl[S_][0][3], fh[S_][0][0], fh[S_][0][1], fh[S_][0][2], fh[S_][0][3]}, o[B], 0, 0, 0); \
                o[B] = __builtin_amdgcn_mfma_f32_32x32x16_bf16(pa1, (bf16x8){fl[S_][1][0], fl[S_][1][1], fl[S_][1][2], fl[S_][1][3], fh[S_][1][0], fh[S_][1][1], fh[S_][1][2], fh[S_][1][3]}, o[B], 0, 0, 0); \
                o[B] = __builtin_amdgcn_mfma_f32_32x32x16_bf16(pa2, (bf16x8){fl[S_][2][0], fl[S_][2][1], fl[S_][2][2], fl[S_][2][3], fh[S_][2][0], fh[S_][2][1], fh[S_][2][2], fh[S_][2][3]}, o[B], 0, 0, 0); \
                o[B] = __builtin_amdgcn_mfma_f32_32x32x16_bf16(pa3, (bf16x8){fl[S_][3][0], fl[S_][3][1], fl[S_][3][2], fl[S_][3][3], fh[S_][3][0], fh[S_][3][1], fh[S_][3][2], fh[S_][3][3]}, o[B], 0, 0, 0); } while (0)
            ATT_VRD(0, 0);
            ATT_VRD(1, 1); asm volatile("s_waitcnt lgkmcnt(8)" ::: "memory"); SBAR(); ATT_VMM(0, 0); SBAR();
            ATT_VRD(2, 0); asm volatile("s_waitcnt lgkmcnt(8)" ::: "memory"); SBAR(); ATT_VMM(1, 1); SBAR();
            ATT_VRD(3, 1); asm volatile("s_waitcnt lgkmcnt(8)" ::: "memory"); SBAR(); ATT_VMM(2, 0); SBAR();
            asm volatile("s_waitcnt lgkmcnt(0)" ::: "memory"); SBAR(); ATT_VMM(3, 1); SBAR();
#undef ATT_VRD
#undef ATT_VMM
        }
        }
        if (j + 1 < NT) { if (j + NS - 1 < NT) ATT_VMWAIT((NS - 2) * IPT); else ATT_VMWAIT(0); }
    }
    }
    (void)C; (void)var_;
#elif ATT_SKEW1
    constexpr bool EXP_EARLY = true;
    const bool trail = wid >= 4;
    __syncthreads();
#pragma unroll
    for (int t = 0; t < NS - 2; ++t) if (t < NT) ATT_ISSUE(t);
    f32x16 p0, p1; float al = 1.f, pmax_ = 0.f; bf16x8 pa0, pa1, pa2, pa3;
    if (NS == 3) ATT_VMWAIT(0); else { if (NT >= 2) ATT_VMWAIT(IPT); else ATT_VMWAIT(0); }
#define ATT_STAGE_A(t) do { __builtin_amdgcn_s_setprio(1); ATT_QKT(p0, p1, t); __builtin_amdgcn_s_setprio(0); ATT_PART_A(p0, p1, t); ATT_PART_B(p0, p1, al, t); ATT_PART_C(p0, p1, t); ATT_FINISH(p0, p1, al); ATT_RESC(al); } while (0)
#define ATT_STAGE_B(t) do { __builtin_amdgcn_s_setprio(1); ATT_PV1(t, 0); ATT_PV1(t, 1); ATT_PV1(t, 2); ATT_PV1(t, 3); __builtin_amdgcn_s_setprio(0); } while (0)
    for (int k = 0; k <= NT; ++k) {
        ATT_BAR();
        if (k + NS - 2 < NT) ATT_ISSUE(k + NS - 2);
        if (!trail) { if (k < NT) { ATT_STAGE_A(k); SBAR(); ATT_STAGE_B(k); } }
        else { if (k >= 1) ATT_STAGE_B(k - 1); SBAR(); if (k < NT) ATT_STAGE_A(k); }
        if (k + 1 < NT) { if (NS > 3 && k + NS - 2 < NT) ATT_VMWAIT((NS - 3) * IPT); else ATT_VMWAIT(0); }
    }
#undef ATT_STAGE_A
#undef ATT_STAGE_B
#else
    constexpr bool EXP_EARLY = (DQK == 64) && !ATT_PROBE_SIMPLE;
    __syncthreads();
#pragma unroll
    for (int t = 0; t < NS - 1; ++t) if (t < NT) ATT_ISSUE(t);
    if (NT >= NS - 1) ATT_VMWAIT((NS - 2) * IPT); else ATT_VMWAIT(0);
    ATT_BAR();
    f32x16 pA0, pA1, pB0, pB1; float alA = 1.f, alB = 1.f, pmax_ = 0.f; bf16x8 pa0, pa1, pa2, pa3;
    ATT_QKT(pA0, pA1, 0); ATT_PARTIAL(pA0, pA1, alA, 0); ATT_RESC(alA);
    if (NT >= 2) { if (NT >= NS - 1) ATT_VMWAIT((NS - 3) * IPT); else ATT_VMWAIT(0); }
    int j = 0;
    if (DQK == 64 && !ATT_PROBE_SIMPLE) {
        for (; j + 2 < NT; j += 2) {
            ATT_STEP(pA0, pA1, alA, pB0, pB1, alB, j, true);
            ATT_STEP(pB0, pB1, alB, pA0, pA1, alA, j + 1, true);
        }
        if (j + 1 < NT) { ATT_STEP(pA0, pA1, alA, pB0, pB1, alB, j, true); ATT_STEP(pB0, pB1, alB, pA0, pA1, alA, j + 1, false); }
        else { ATT_STEP(pA0, pA1, alA, pB0, pB1, alB, j, false); }
    } else {
        for (; j + 1 < NT; j += 2) {
            ATT_STEP(pA0, pA1, alA, pB0, pB1, alB, j, ((j) + 1 < NT));
            ATT_STEP(pB0, pB1, alB, pA0, pA1, alA, j + 1, ((j) + 2 < NT));
        }
        if (j < NT) ATT_STEP(pA0, pA1, alA, pB0, pB1, alB, j, false);
    }
#endif
#undef ATT_BAR
#undef ATT_SG
#undef ATT_ACTIVE
#undef ATT_QKT
#undef ATT_PARTIAL
#undef ATT_PART_A
#undef ATT_PART_B
#undef ATT_PART_C
#undef ATT_PK4
#undef ATT_FINISH
#undef ATT_RESC
#undef ATT_PV1
#undef ATT_PVX
#undef ATT_CHUNK
#undef ATT_EXPR
#undef ATT_MAX2
#undef ATT_MM
#undef ATT_TRR
#undef ATT_STEP
#undef ATT_ROW0
#undef ATT_ISSUE
#undef ATT_VMWAIT
}
__device__ __forceinline__ void row_recip(float l_reg, LAS unsigned char* lds, float (&rli)[16], const int wid) {
    const int lane = lane_opq(), r32 = lane & 31, hi = lane >> 5;
    LAS float* wsf = (LAS float*)(lds + LDS_WS) + wid * 64;
    if (hi == 0) wsf[r32] = l_reg; LDS_WAIT();
#pragma unroll
    for (int r = 0; r < 16; ++r) rli[r] = __builtin_amdgcn_rcpf(wsf[crow(r, hi)]);
    LDS_WAIT();
}
__device__ __forceinline__ void store_o(const f32x16 (&o)[4], const float (&rli)[16], bf16_t* Ow, int ldo) {
    const int lane = lane_opq(), r32 = lane & 31, hi = lane >> 5;
#pragma unroll
    for (int r = 0; r < 16; ++r) { GAS bf16_t* p = (GAS bf16_t*)Ow + (size_t)(4 * hi) * ldo + r32; asm volatile("" : "+v"(p)); p += (size_t)crow(r, 0) * ldo;
#pragma unroll
        for (int d0 = 0; d0 < 4; ++d0) p[d0 * 32] = (bf16_t)(cvtpk(o[d0][r] * rli[r], 0.f) & 0xffffu); }
}
}
struct Args { const float* in[27]; float* out; unsigned char* ws; int ph_lo, ph_hi; int var, pad; };
enum { I_X = 0, I_C, I_CTX, I_CCTX, I_ADA_W1, I_ADA_W2, I_ADA_B, I_LN_G, I_LN_B, I_MLP_W1, I_MLP_W2, I_DA_WQKV, I_DA_WO, I_DA_LQ1, I_DA_LK1, I_DA_LQ2, I_DA_LK2, I_DA_SUBG,
       I_MLA_WDOWN, I_MLA_QG, I_MLA_WUQ, I_MLA_KVG, I_MLA_WUKV, I_MLA_WO, I_NA_WQKV, I_NA_WO, I_NA_RPB };

static_assert(sizeof(Args) == 248, "Args layout");
namespace cvs {
constexpr int NMAT = 18;
__host__ __device__ constexpr int count(int m) {
    return (m == 4) ? 64 * 33 : (m == 5) ? 24 * 192 : (m == 6) ? 8 * 256 : (m == 7) ? 128 * 64
         : ((m < 4 ? m : (m < 10 ? m - 6 : (m < 14 ? m - 10 : m - 14))) == 0) ? 64 * 192 : ((m < 4 ? m : (m < 10 ? m - 6 : (m < 14 ? m - 10 : m - 14))) == 1) ? 64 * 64 : 64 * 256; }
__host__ __device__ constexpr int start(int m) { int s = 0; for (int i = 0; i < m; ++i) s += count(i); return s; }
constexpr int TOTAL = start(NMAT);
static_assert(TOTAL == 197184 && count(8) == 16384 && count(9) == 16384 && count(0) == 12288 && count(1) == 4096, "stream");
#ifndef CVT_PER_CU
#define CVT_PER_CU 130
#endif
#ifndef CVT_IN_ATT
#define CVT_IN_ATT 0
#endif
constexpr int NWIN = 8;
__host__ __device__ constexpr int win_phase(int w) { using namespace cfg; return w == 0 ? PH_L0 + 0 : w == 1 ? PH_L0 + 6 : w == 2 ? PH_L0 + 10 + 0 : w == 3 ? PH_L0 + 10 + 2 : w == 4 ? PH_L0 + 10 + 6 : w == 5 ? PH_L0 + 20 + 0 : w == 6 ? PH_L0 + 20 + 6 : PH_L0 + 30 + 0; }
__host__ __device__ constexpr int win_cap(int w) { return CVT_IN_ATT ? 0 : w == 0 ? 160 * CVT_PER_CU : w == 1 ? 128 * (CVT_PER_CU * 165 / 130) : w == 2 ? 206 * (CVT_PER_CU * 100 / 130) : w == 3 ? 160 * (CVT_PER_CU * 45 / 130) : w == 4 ? 128 * (CVT_PER_CU * 165 / 130) : w == 5 ? 160 * CVT_PER_CU : w == 6 ? 128 * (CVT_PER_CU * 165 / 130) : 160 * CVT_PER_CU; }
__host__ __device__ constexpr int cap_before(int phase) { int s = 0; for (int w = 0; w < NWIN; ++w) if (win_phase(w) < phase) s += win_cap(w); return s; }
__host__ __device__ constexpr int use_phase(int m) { using namespace cfg;
    const int l = m < 4 ? 0 : (m < 10 ? 1 : (m < 14 ? 2 : 3)), j = m < 4 ? m : (m < 10 ? m - 4 : (m < 14 ? m - 10 : m - 14));
    return PH_L0 + 10 * l + (l == 1 ? (j == 0 ? 0 : j <= 2 ? 2 : j == 3 ? 4 : j == 4 ? 6 : 7) : (j == 0 ? 0 : j == 1 ? 4 : j == 2 ? 6 : 7)); }
__host__ __device__ constexpr int prefix() { int S = 0; for (int m = 0; m < NMAT; ++m) { const int need = start(m) + count(m) - cap_before(use_phase(m)); if (need > S) S = need; } return S; }
constexpr int CVT_S = CVT_IN_ATT ? count(0) : prefix();
__host__ __device__ constexpr int win_lo(int w) { int s = CVT_S; for (int i = 0; i < w; ++i) s += win_cap(i); return s < TOTAL ? s : TOTAL; }
__host__ __device__ constexpr int win_hi(int w) { const int s = win_lo(w) + win_cap(w); return s < TOTAL ? s : TOTAL; }
}
__global__ void __launch_bounds__(512, 2) fwd(Args a) {
    using namespace cfg;
    extern __shared__ __attribute__((aligned(16))) unsigned char lds_raw[];
    LAS unsigned char* lds = (LAS unsigned char*)lds_raw;
    LAS unsigned char* ring = lds + RING_OFF;
    const int tid0 = threadIdx.x;
    const int wave_id = __builtin_amdgcn_readfirstlane(tid0 >> 6);
    for (int u = tid0; u < LDSCTL_BYTES / 4; u += 512) ((LAS unsigned*)lds)[u] = 0u;
    __syncthreads();
    const int lo = a.ph_lo, hi = a.ph_hi;
#ifdef PROBE_VAR
    const int avar = a.var;
#else
    constexpr int avar = 0;
#endif
    if (hi - lo > 1) (void)xcd_barrier_post((unsigned*)(ARG_WS() + WS_CTL) + 4096, (volatile LAS unsigned*)lds, tid0 == 0);
#define IN(k) (lo <= (k) && (k) < hi)
#define PHASE_IDS() int tid = wave_id * 64 + lane_id_opq(); asm volatile("" : "+v"(tid)); int G = gridDim.x, bx = blockIdx.x; asm volatile("" : "+s"(G), "+s"(bx)); \
    const int vcu = (G % 8 == 0) ? (bx % 8) * (G / 8) + bx / 8 : bx;   \
    int wave = wave_id; asm volatile("" : "+s"(wave)); const int NGW = G * 8, lane = tid & 63, gw = vcu * 8 + wave; (void)lane; (void)gw; (void)NGW
#define CVT_STREAM(lo_, hi_, r_, nr_) do { LAS float* scr_ = (LAS float*)(ring + wave * 16640); int st_ = 0; \
        _Pragma("unroll 1") for (int m_ = 0; m_ < cvs::NMAT; ++m_) { const int cn_ = cvs::count(m_); const int a_ = (lo_) > st_ ? (lo_) - st_ : 0, b_ = ((hi_) - st_) < cn_ ? (hi_) - st_ : cn_; \
            if (a_ < b_) { const int l_ = m_ < 4 ? 0 : (m_ < 10 ? 1 : (m_ < 14 ? 2 : 3)), j_ = m_ < 4 ? m_ : (m_ < 10 ? m_ - 4 : (m_ < 14 ? m_ - 10 : m_ - 14)); \
                const float* W_; bf16_t* T_; int K_, N_; \
                if (l_ == 1) { \
                    if (j_ == 0) { W_ = INP(I_MLA_WDOWN); T_ = (bf16_t*)(ARG_WS() + WS_WDOWN); K_ = 4096; N_ = MLA_DOWN; } \
                    else if (j_ == 1) { W_ = INP(I_MLA_WUQ); T_ = (bf16_t*)(ARG_WS() + WS_WUQ); K_ = 1536; N_ = 12288; } \
                    else if (j_ == 2) { W_ = INP(I_MLA_WUKV); T_ = (bf16_t*)(ARG_WS() + WS_WUKV); K_ = 512; N_ = 16384; } \
                    else if (j_ == 3) { W_ = INP(I_MLA_WO); T_ = (bf16_t*)(ARG_WS() + WS_WOMLA); K_ = 8192; N_ = 4096; } \
                    else if (j_ == 4) { W_ = INP(I_MLP_W1) + (size_t)1 * 4096 * 16384; T_ = (bf16_t*)(ARG_WS() + WS_W1 + 1 * SZ_W1); K_ = 4096; N_ = 16384; } \
                    else { W_ = INP(I_MLP_W2) + (size_t)1 * 4096 * 16384; T_ = (bf16_t*)(ARG_WS() + WS_W2 + 1 * SZ_W1); K_ = 16384; N_ = 4096; } \
                } else { const int sl_ = l_ == 3 ? 1 : 0; \
                    if (j_ == 0) { W_ = l_ == 2 ? INP(I_NA_WQKV) : INP(I_DA_WQKV) + (size_t)sl_ * 4096 * 12288; T_ = l_ == 2 ? (bf16_t*)(ARG_WS() + WS_WQKV_NA) : (bf16_t*)(ARG_WS() + WS_WQKV_DA + sl_ * SZ_WQKV); K_ = 4096; N_ = 12288; } \
                    else if (j_ == 1) { W_ = l_ == 2 ? INP(I_NA_WO) : INP(I_DA_WO) + (size_t)sl_ * 4096 * 4096; T_ = l_ == 2 ? (bf16_t*)(ARG_WS() + WS_WO_NA) : (bf16_t*)(ARG_WS() + WS_WO_DA + sl_ * SZ_WO); K_ = 4096; N_ = 4096; } \
                    else if (j_ == 2) { W_ = INP(I_MLP_W1) + (size_t)l_ * 4096 * 16384; T_ = (bf16_t*)(ARG_WS() + WS_W1 + l_ * SZ_W1); K_ = 4096; N_ = 16384; } \
                    else { W_ = INP(I_MLP_W2) + (size_t)l_ * 4096 * 16384; T_ = (bf16_t*)(ARG_WS() + WS_W2 + l_ * SZ_W1); K_ = 16384; N_ = 4096; } } \
                cvt_matrix(W_, K_, N_, T_, scr_, (r_), (nr_), lane, a_, b_); } \
            st_ += cn_; } } while (0)
#define CVT_WINDOW(lo_, hi_, rem_) do { const int wl_ = (lo_), wh_ = (hi_); if (bx >= (rem_) && wl_ < wh_) { CVT_STREAM(wl_, wh_, (bx - (rem_)) * 8 + wave, (G - (rem_)) * 8); } } while (0)
#define SEAM(k) do { if (IN(k) && IN((k) + 1)) { XcdBarrier bar_; bar_.bar = (unsigned*)(ARG_WS() + WS_CTL) + 4096; bar_.x = xb_xcc_id(); bar_.st = (volatile LAS unsigned*)lds; xcd_barrier(bar_, wave_id == 0 && lane_id_opq() == 0); } } while (0)
#define tab ((float*)(ARG_WS() + WS_TAB))
#define tpart ((float*)(ARG_WS() + WS_TPART))
#define MOD ((float*)(ARG_WS() + WS_MOD))
#define X ((h16_t*)(ARG_WS() + WS_X))
#define H ((bf16_t*)(ARG_WS() + WS_H))
#define QKV ((bf16_t*)(ARG_WS() + WS_QKV))
#define BIG ((bf16_t*)(ARG_WS() + WS_BIG))
#define DOWN ((float*)(ARG_WS() + WS_DOWN))
#define CQ ((bf16_t*)(ARG_WS() + WS_CQ))
#define CKV ((bf16_t*)(ARG_WS() + WS_CKV))
#define KR ((bf16_t*)(ARG_WS() + WS_KR))
#define OB ((bf16_t*)(ARG_WS() + WS_O))

#ifndef SKIP_CVT
    if (IN(PH_CVT)) {
        PHASE_IDS();
#ifdef PROBE_CVT2
#pragma unroll 1
        for (int rep_ = 0; rep_ < 2; ++rep_) {
#endif
        LAS float* scr = (LAS float*)(ring + wave * 16640);
        CVT_STREAM(0, cvs::CVT_S, gw, NGW);
#ifdef PROBE_CVT2
        }
#endif
        { u32x4* z = (u32x4*)(ARG_WS() + WS_WDOWN + (size_t)MLA_DOWN * 4096 * 2); const int n16 = (MLA_DOWN_PAD - MLA_DOWN) * 4096 * 2 / 16;
          for (int i = gw * 64 + lane; i < n16; i += NGW * 64) z[i] = (u32x4){0u, 0u, 0u, 0u}; }
        if (bx == 0) for (int t = tid; t < 1024; t += 512) { const int pos = t >> 4, j = t & 15;
            const float inv = __builtin_amdgcn_exp2f(-(float)j * (13.287712379549449f / 16.f)); const float ang = (float)pos * inv;
            tab[t] = __cosf(ang); tab[1024 + t] = __sinf(ang); }
        __syncthreads();
        for (int u = vcu; u < 256; u += G) {
            const int l = u >> 6, jc = (u >> 3) & 7, ksl = u & 7;
            const float* w1 = INP(I_ADA_W1) + (size_t)l * 4096 * 512 + jc * 64 + lane;
            const int kbase = ksl * 512 + wave * 64;
            float s0 = 0.f, s1 = 0.f, s2 = 0.f;
#pragma unroll 1
            for (int k0 = 0; k0 < 64; k0 += 32) { float w[32];
#pragma unroll
                for (int kk = 0; kk < 32; ++kk) w[kk] = NTL(&w1[(size_t)(kbase + k0 + kk) * 512]);
#pragma unroll
                for (int kk = 0; kk < 32; ++kk) { const int k = kbase + k0 + kk; s0 += silu_f(INP(I_C)[k]) * w[kk]; s1 += silu_f(INP(I_C)[4096 + k]) * w[kk]; s2 += silu_f(INP(I_CCTX)[k]) * w[kk]; } }
            LAS float* red = (LAS float*)ring;
            red[(wave * 3 + 0) * 64 + lane] = s0; red[(wave * 3 + 1) * 64 + lane] = s1; red[(wave * 3 + 2) * 64 + lane] = s2;
            __syncthreads();
            if (tid < 192) { const int c = tid >> 6, j = tid & 63; float s = 0.f;
#pragma unroll
                for (int w = 0; w < 8; ++w) s += red[(w * 3 + c) * 64 + j];
                tpart[((l * 8 + ksl) * 3 + c) * 512 + jc * 64 + j] = s; }
            __syncthreads();
        }
    }
#endif
    SEAM(PH_CVT);
    if (IN(PH_MOD)) {
        PHASE_IDS();
        LAS float* tl = (LAS float*)ring;
        for (int u = vcu; u < 4 * 48; u += G) {
            const int l = u / 48, n = (u % 48) * 512 + tid;
            __syncthreads();
            for (int e = tid; e < 1536; e += 512) { const int c = e >> 9, j = e & 511; float s = 0.f;
#pragma unroll
                for (int ks = 0; ks < 8; ++ks) s += tpart[((l * 8 + ks) * 3 + c) * 512 + j];
                tl[e] = s; }
            __syncthreads();
            const float* w2 = INP(I_ADA_W2) + (size_t)l * 512 * 24576 + n;
            float s0 = 0.f, s1 = 0.f, s2 = 0.f;
#pragma unroll 1
            for (int j0 = 0; j0 < 512; j0 += 32) {
                float w[32];
#pragma unroll
                for (int j = 0; j < 32; ++j) w[j] = NTL(&w2[(size_t)(j0 + j) * 24576]);
#pragma unroll
                for (int j = 0; j < 32; ++j) { s0 += tl[j0 + j] * w[j]; s1 += tl[512 + j0 + j] * w[j]; s2 += tl[1024 + j0 + j] * w[j]; } }
            const float bb = INP(I_ADA_B)[l * 24576 + n];
            MOD[(size_t)(l * 3 + 0) * 24576 + n] = s0 + bb; MOD[(size_t)(l * 3 + 1) * 24576 + n] = s1 + bb; MOD[(size_t)(l * 3 + 2) * 24576 + n] = s2 + bb;
        }
    }
    SEAM(PH_MOD);
    if (IN(PH_INIT)) {
        PHASE_IDS();
        for (int row = gw; row < MALL; row += NGW) {
            const float* src = row < MLAT ? INP(I_X) + (size_t)row * D : INP(I_CTX) + (size_t)(row - MLAT) * D;
            const int cond = row < SEQ ? 0 : (row < MLAT ? 1 : 2);
            const float* m = MOD + (size_t)(0 * 3 + cond) * 24576;
            init_row(src, X + (size_t)row * D, H + (size_t)row * D, m + 1 * 4096, m + 0 * 4096, lane);
        }
    }
    SEAM(PH_INIT);

#pragma unroll 1
    for (int sl = 0; sl < 2 * DEPTH; ++sl) {
        const int l = sl >> 1, sub = sl & 1;
        const int kind = l % 3, slot = l / 3, pb = PH_L0 + PH_PER_LAYER * l;
        const bool with_ctx = l < DEPTH - 1;
        const int Mrows = with_ctx ? MALL : MLAT;
        const float* modl = MOD + (size_t)l * 3 * 24576;
        const int o_ld = kind == 1 ? 8192 : 4096;
        if (sub == 0) {
#ifndef SKIP_G0
        if (IN(pb + 0)) {
            PHASE_IDS();
            if (kind == 1) {
                pg8::Gemm g{H, (const bf16_t*)(ARG_WS() + WS_WDOWN), MALL, MLA_DOWN_PAD, 4096, 4096, 4096}; pg8::StaticOrder S; S.init(MALL, MLA_DOWN_PAD, G, bx);
                pg8::EpiF32 E{DOWN, MLA_DOWN_PAD};
                pg8::gemm_phase<pg8::EpiF32, pg8::StaticOrder, true, true>(ring, g, S, E, wave_id);
                CVT_WINDOW(cvs::win_lo(2), cvs::win_hi(2), (34 * 9) % G);
            } else {
                const bf16_t* Wt = kind == 0 ? (const bf16_t*)(ARG_WS() + WS_WQKV_DA + slot * SZ_WQKV) : (const bf16_t*)(ARG_WS() + WS_WQKV_NA);
                pg8::Gemm g{H, Wt, MALL, 12288, 4096, 4096, 4096}; pg8::StaticOrder S; S.init(MALL, 12288, G, bx);
                pg8::EpiRope<0> E{QKV, 12288, tab, kind == 0 ? 8192 : 0, 4096, (kind == 0 ? 0.125f : 0.08838834764831845f) * LOG2E};
                pg8::gemm_phase<pg8::EpiRope<0>, pg8::StaticOrder, true, true>(ring, g, S, E, wave_id);
                CVT_WINDOW(l == 0 ? cvs::win_lo(0) : (l == 2 ? cvs::win_lo(5) : cvs::win_lo(7)), l == 0 ? cvs::win_hi(0) : (l == 2 ? cvs::win_hi(5) : cvs::win_hi(7)), (34 * 48) % G);
            }
        }
#endif
        SEAM(pb + 0);
        if (kind == 1) {
            if (IN(pb + 1)) {
        PHASE_IDS();
                for (int row = gw; row < MALL; row += NGW)
                    mla_norm_row(DOWN + (size_t)row * MLA_DOWN_PAD, CQ + (size_t)row * MLA_QR, CKV + (size_t)row * MLA_KVR, KR + (size_t)row * 64, INP(I_MLA_QG), INP(I_MLA_KVG), tab, row, lane);
            }
            SEAM(pb + 1);
#ifndef SKIP_G2
            if (IN(pb + 2)) {
            PHASE_IDS();
                { pg8::Gemm g{CQ, (const bf16_t*)(ARG_WS() + WS_WUQ), MALL, 12288, MLA_QR, MLA_QR, MLA_QR}; pg8::StaticOrder S; S.init(MALL, 12288, G, bx);
                  pg8::EpiRope<1> E{QKV, 12288, tab, 0, 12288, 0.07216878364870322f * LOG2E};
                  pg8::gemm_phase<pg8::EpiRope<1>, pg8::StaticOrder, true, true>(ring, g, S, E, wave_id); }
                CVT_WINDOW(cvs::win_lo(3), cvs::win_hi(3), (34 * 48) % G);
                __syncthreads();
                { pg8::Gemm g{CKV, (const bf16_t*)(ARG_WS() + WS_WUKV), MALL, 16384, MLA_KVR, MLA_KVR, MLA_KVR}; pg8::StaticOrder S; S.init(MALL, 16384, G, bx);
                  pg8::EpiBf16<0> E{BIG, 16384};
                  pg8::gemm_phase<pg8::EpiBf16<0>, pg8::StaticOrder, true, true>(ring, g, S, E, wave_id); }
            }
#endif
            SEAM(pb + 2);
        }
        if (IN(pb + 3)) {
        PHASE_IDS();
#ifdef PROBE_ATT2
#pragma unroll 1
        for (int rep_ = 0; rep_ < 2; ++rep_) {
#endif
            if (false) {}
#ifndef SKIP_DA
            else if (kind == 0) {
                const float lam_init = l == 0 ? 0.2f : 0.55605820f;
                const float d1 = wave_sum(INP(I_DA_LQ1)[slot * 64 + lane] * INP(I_DA_LK1)[slot * 64 + lane]);
                const float d2 = wave_sum(INP(I_DA_LQ2)[slot * 64 + lane] * INP(I_DA_LK2)[slot * 64 + lane]);
                const float lam = expf(d1) - expf(d2) + lam_init;
                const float Cs = 0.125f * LOG2E;
                const float* subg = INP(I_DA_SUBG) + slot * 128;
                const int NUL = 1024, NU = NUL + (with_ctx ? 64 : 0);
                int cvt_at = (CVT_IN_ATT && l == 0) ? vcu + (vcu & 3) * G : -1;
                for (int u = vcu; u < NU; u += G) {
                    if (u == cvt_at) { __syncthreads(); CVT_STREAM(cvs::CVT_S, cvs::TOTAL, gw, NGW); __syncthreads(); }
                    int b, h, row0, NT;
                    if (u < NUL) { const int qb = u & 15; h = (u >> 4) & 31; b = u >> 9; row0 = b * SEQ + qb * 256; NT = 68; }
                    else { const int v = u - NUL; h = v & 31; b = v >> 5; row0 = MLAT + b * CTX; NT = 4; }
                    f32x16 o[4]; float l_reg; float rli[16];
#pragma unroll 1
                    for (int c = 0; c < 2; ++c) {
                        att::Src S; S.Q = QKV + (size_t)row0 * 12288 + (2 * h + c) * 64; S.ldq = 12288; S.K1 = QKV + 4096 + (2 * h + c) * 64; S.ldk1 = 12288; S.K2 = nullptr; S.ldk2 = 0;
                        S.V = QKV + 8192 + h * 128; S.ldv = 12288; S.ctx_row0 = MLAT + b * CTX; S.lat_row0 = b * SEQ; S.NT = NT;
                        att::attn_core<64, 0>(S, Cs, ring, o, l_reg, wave_id, avar, 0, 0, 0);
                        att::row_recip(l_reg, ring, rli, wave_id);
                        if (c == 0) { float* stash = (float*)(ARG_WS() + WS_STASH) + (size_t)bx * 32768 + wave * 4096 + att::lane_opq();
#pragma unroll
                            for (int r = 0; r < 16; ++r) { GAS float* sp = (GAS float*)stash; asm volatile("" : "+v"(sp)); sp += r * 256;
#pragma unroll
                                for (int d0 = 0; d0 < 4; ++d0) sp[d0 * 64] = o[d0][r] * rli[r]; }
                        }
                    }
                    const int lane2 = att::lane_opq(), r32 = lane2 & 31, hi = lane2 >> 5; const float* stash = (const float*)(ARG_WS() + WS_STASH) + (size_t)bx * 32768 + wave * 4096 + lane2;
                    bf16_t* Ow = OB + (size_t)(row0 + wave * 32) * 4096 + h * 128;
                    float gsub[4];
#pragma unroll
                    for (int d0 = 0; d0 < 4; ++d0) gsub[d0] = subg[d0 * 32 + r32] * (1.f - lam_init);
                    float stv[16][4];
#pragma unroll
                    for (int w4 = 0; w4 < 4; ++w4) { const GAS float* sp = (const GAS float*)stash + w4 * 1024; asm volatile("" : "+v"(sp));
#pragma unroll
                        for (int e = 0; e < 16; ++e) stv[w4 * 4 + (e >> 2)][e & 3] = sp[e * 64]; }
#pragma unroll
                    for (int r = 0; r < 16; ++r) { float x[4]; float s = 0.f;
#pragma unroll
                        for (int d0 = 0; d0 < 4; ++d0) { x[d0] = stv[r][d0] - lam * (o[d0][r] * rli[r]); s += x[d0] * x[d0]; }
                        s += __shfl_xor(s, 1); s += __shfl_xor(s, 2); s += __shfl_xor(s, 4); s += __shfl_xor(s, 8); s += __shfl_xor(s, 16);
                        float eps_ = 1e-5f; asm volatile("" : "+s"(eps_)); const float rs = __builtin_amdgcn_rsqf(s * (1.f / 128.f) + eps_);
                        GAS bf16_t* p = (GAS bf16_t*)Ow + (size_t)(4 * hi) * 4096 + r32; asm volatile("" : "+v"(p)); p += (size_t)att::crow(r, 0) * 4096;
#pragma unroll
                        for (int d0 = 0; d0 < 4; ++d0) p[d0 * 32] = (bf16_t)(cvtpk(x[d0] * rs * gsub[d0], 0.f) & 0xffffu);
                        asm volatile("" ::: "memory"); }
                }
            }
#endif
#ifndef SKIP_MLA
            else if (kind == 1) {
                const float Cs = 0.07216878364870322f * LOG2E;
                const int NUL = 2048, NU = NUL + (with_ctx ? 128 : 0);
                for (int u = vcu; u < NU; u += G) {
                    int b, h, row0, NT;
                    if (u < NUL) { const int qb = u & 15; h = (u >> 4) & 63; b = u >> 10; row0 = b * SEQ + qb * 256; NT = 68; }
                    else { const int v = u - NUL; h = v & 63; b = v >> 6; row0 = MLAT + b * CTX; NT = 4; }
                    att::Src S; S.Q = QKV + (size_t)row0 * 12288 + h * 192; S.ldq = 12288; S.K1 = BIG + h * 256; S.ldk1 = 16384; S.K2 = KR; S.ldk2 = 64;
                    S.V = BIG + h * 256 + 128; S.ldv = 16384; S.ctx_row0 = MLAT + b * CTX; S.lat_row0 = b * SEQ; S.NT = NT;
                    f32x16 o[4]; float l_reg; float rli[16];
                    att::attn_core<192, 0>(S, Cs, ring, o, l_reg, wave_id, 0, 0, 0, 0);
                    att::row_recip(l_reg, ring, rli, wave_id);
                    att::store_o(o, rli, OB + (size_t)(row0 + wave * 32) * 8192 + h * 128, 8192);
                }
            }
#endif
#ifndef SKIP_NA
            else if (kind == 2) {
                const float Cs = 0.08838834764831845f * LOG2E;
                const int NUL = 1024, NU = NUL + (with_ctx ? 64 : 0);
                LAS float* btab = (LAS float*)(ring + att::LDS_BIAS) + 64;
                for (int u = vcu; u < NU; u += G) {
                    int b, h, row0, NT, R0 = 0, krlo = 0;
                    if (u < NUL) { const int qb = u & 15; h = (u >> 4) & 31; b = u >> 9; row0 = b * SEQ + qb * 256; R0 = 4 * qb;
                        krlo = R0 - 4; krlo = krlo < 0 ? 0 : (krlo > 56 ? 56 : krlo); int krhi = R0 - 1; krhi = krhi < 0 ? 0 : (krhi > 56 ? 56 : krhi); krhi += 7; NT = 4 + (krhi - krlo + 1); }
                    else { const int v = u - NUL; h = v & 31; b = v >> 5; row0 = MLAT + b * CTX; NT = 4; }
                    __syncthreads();
                    const int t2 = wave_id * 64 + att::lane_opq();
                    if (t2 < 15 * 32) { const int ri = t2 >> 5, ci = t2 & 31; btab[t2] = ci < 31 ? INP(I_NA_RPB)[(h * 15 + ri) * 31 + ci] * LOG2E : 0.f; }
                    att::Src S; S.Q = QKV + (size_t)row0 * 12288 + h * 128; S.ldq = 12288; S.K1 = QKV + 4096 + h * 128; S.ldk1 = 12288; S.K2 = nullptr; S.ldk2 = 0;
                    S.V = QKV + 8192 + h * 128; S.ldv = 12288; S.ctx_row0 = MLAT + b * CTX; S.lat_row0 = b * SEQ + 64 * krlo; S.NT = NT;
                    f32x16 o[4]; float l_reg; float rli[16];
                    att::attn_core<128, 1>(S, Cs, ring, o, l_reg, wave_id, 0, R0 + (wave >> 1), krlo, (wave & 1) * 32 + (att::lane_opq() & 31));
                    att::row_recip(l_reg, ring, rli, wave_id);
                    att::store_o(o, rli, OB + (size_t)(row0 + wave * 32) * 4096 + h * 128, 4096);
                }
            }
#endif
#ifdef PROBE_ATT2
        }
#endif
        }
        SEAM(pb + 3);
        } else {
#ifndef SKIP_G6
        if (IN(pb + 6)) {
            PHASE_IDS();
            pg8::Gemm g{H, (const bf16_t*)(ARG_WS() + WS_W1 + l * SZ_W1), Mrows, DFF, 4096, 4096, 4096}; pg8::StaticOrder S; S.init(Mrows, DFF, G, bx);
            pg8::EpiBf16<1> E{BIG, DFF};
            pg8::gemm_phase<pg8::EpiBf16<1>, pg8::StaticOrder, true, true>(ring, g, S, E, wave_id);
            if (with_ctx) CVT_WINDOW(l == 0 ? cvs::win_lo(1) : (l == 1 ? cvs::win_lo(4) : cvs::win_lo(6)), l == 0 ? cvs::win_hi(1) : (l == 1 ? cvs::win_hi(4) : cvs::win_hi(6)), (34 * 64) % G);
        }
#endif
        SEAM(pb + 6);
        }
        const int pr = pb + 4 + 3 * sub;
#ifndef SKIP_G4
        if (IN(pr)) {
            PHASE_IDS();
            const bf16_t* Wt = sub ? (const bf16_t*)(ARG_WS() + WS_W2 + l * SZ_W1)
                                   : (kind == 0 ? (const bf16_t*)(ARG_WS() + WS_WO_DA + slot * SZ_WO) : (kind == 1 ? (const bf16_t*)(ARG_WS() + WS_WOMLA) : (const bf16_t*)(ARG_WS() + WS_WO_NA)));
            const bf16_t* Ain = sub ? BIG : OB; const int Kr = sub ? DFF : o_ld;
            { pg8::Gemm g{Ain, Wt, MLAT, 4096, Kr, Kr, Kr}; pg8::StaticOrder S; S.init(MLAT, 4096, G, bx);
              const int pln = 2 * l + sub - 1;
              pg8::EpiResid E{modl + (2 + 3 * sub) * 4096, DN_ALPHA, pln};
              pg8::gemm_phase<pg8::EpiResid, pg8::StaticOrder, true, true>(ring, g, S, E, wave_id); }
            if (with_ctx) {
              pg8::Gemm g{Ain + (size_t)MLAT * Kr, Wt, MCTX, 4096, Kr / 8, Kr, Kr}; pg8::SplitKOrder S; S.init(MCTX, 4096, 8, G, bx);
              pg8::EpiSlabBf16 E{(bf16_t*)(ARG_WS() + WS_PART)};
              pg8::gemm_phase<pg8::EpiSlabBf16, pg8::SplitKOrder, true, true>(ring, g, S, E, wave_id); }
        }
#endif
        SEAM(pr);
        if (IN(pr + 1)) {
            PHASE_IDS();
            const float* gg = INP(I_LN_G) + (size_t)(l * 2 + sub) * D; const float* bb = INP(I_LN_B) + (size_t)(l * 2 + sub) * D;
            const bool last = (sub == 1) && (l + 1 == DEPTH);
            const float* modn = sub ? MOD + (size_t)(l + 1 < DEPTH ? l + 1 : l) * 3 * 24576 : modl;
            const int isc = sub ? 1 : 4, ish = sub ? 0 : 3;
            const float* gate = modl + (size_t)2 * 24576 + (2 + 3 * sub) * 4096;
            LAS float* lt = (LAS float*)ring;
            for (int i = tid; i < 3 * 4096; i += 512) { const int c = i >> 12, col = i & 4095; const float g_ = gg[col], b_ = bb[col];
                float sc_ = 0.f, sh_ = 0.f; if (!last) { const float* m = modn + (size_t)c * 24576; sc_ = m[isc * 4096 + col]; sh_ = m[ish * 4096 + col]; }
                lt[(c * 2 + 0) * 4096 + col] = g_ * (1.f + sc_); lt[(c * 2 + 1) * 4096 + col] = b_ * (1.f + sc_) + sh_; }
            __syncthreads();
            int r_lo = gw, r_hi = Mrows, r_st = NGW;
            if (with_ctx) { if (wave < 2) { r_lo = MLAT + vcu * 2 + wave; r_hi = MALL; r_st = 2 * G; } else { r_lo = vcu * 6 + wave - 2; r_hi = MLAT; r_st = 6 * G; } }
            const int pln = 2 * l + sub - 1;
            if (!last) ln_rows<false>(r_lo, r_hi, r_st, X, H, nullptr, (float*)(ARG_WS() + WS_STATS), lt, lane, with_ctx ? (const bf16_t*)(ARG_WS() + WS_PART) : nullptr, gate, DN_ALPHA,
                                      pln >= 0, INP(I_LN_G) + (size_t)(pln >= 0 ? pln : 0) * D, INP(I_LN_B) + (size_t)(pln >= 0 ? pln : 0) * D);
            else ln_rows<true>(r_lo, r_hi, r_st, X, nullptr, ARG_OUT(), nullptr, lt, lane, nullptr, nullptr, 0.f, false, nullptr, nullptr);
        }
        if (sl + 1 < 2 * DEPTH) SEAM(pr + 1);
    }
#undef IN
#undef SEAM
}

#undef INP
#undef ARG_OUT
#undef ARG_WS
#undef tab
#undef tpart
#undef MOD
#undef X
#undef H
#undef QKV
#undef BIG
#undef DOWN
#undef CQ
#undef CKV
#undef KR
#undef OB
extern "C" void kernel_launch(void* const* d_in, const int* in_sizes, int n_in, void* d_out, int out_size, void* d_ws, size_t ws_size, hipStream_t stream) {
    using namespace cfg;
    static int grid = 0;
    if (grid == 0) {
        if (n_in != 27 || in_sizes[0] != MLAT * D || out_size != MLAT * D || ws_size < WS_END) {
            fprintf(stderr, "kernel_launch: shape mismatch: n_in %d in0 %d out %d ws %zu (need %zu); nothing launched\n", n_in, n_in > 0 ? in_sizes[0] : -1, out_size, ws_size, (size_t)WS_END); grid = -1; return; }
        int dev = 0, cus = 0, per_cu = 0;
        if (hipGetDevice(&dev) != hipSuccess || hipDeviceGetAttribute(&cus, hipDeviceAttributeMultiprocessorCount, dev) != hipSuccess) { fprintf(stderr, "kernel_launch: device query failed\n"); grid = -1; return; }
        if (hipFuncSetAttribute((const void*)fwd, hipFuncAttributeMaxDynamicSharedMemorySize, LDS_BYTES) != hipSuccess) { fprintf(stderr, "kernel_launch: hipFuncSetAttribute(%d B LDS) failed\n", LDS_BYTES); grid = -1; return; }
        if (hipOccupancyMaxActiveBlocksPerMultiprocessor(&per_cu, (const void*)fwd, 512, LDS_BYTES) != hipSuccess || per_cu < 1) {
            fprintf(stderr, "kernel_launch: occupancy query reports %d workgroups per CU\n", per_cu); }
        (void)hipGetLastError();
        grid = cus;
    }
    if (grid < 0) return;
    if (hipMemsetAsync((char*)d_ws + WS_CTL, 0, CTL_ZERO_BYTES, stream) != hipSuccess) { fprintf(stderr, "kernel_launch: memset failed\n"); return; }
    Args a{};
    for (int i = 0; i < 27; ++i) a.in[i] = (const float*)d_in[i];
    a.out = (float*)d_out; a.ws = (unsigned char*)d_ws;
#if MK_ONE_LAUNCH
    a.ph_lo = 0; a.ph_hi = PH_END;
    hipLaunchKernelGGL(fwd, dim3(grid), dim3(512), LDS_BYTES, stream, a);
#else
    for (int p = 0; p < PH_END; ++p) {
        if (p >= PH_L0) { const int l = (p - PH_L0) / PH_PER_LAYER, k = (p - PH_L0) % PH_PER_LAYER; if (k == 9) continue; if ((k == 1 || k == 2) && (l % 3) != 1) continue; }
        a.ph_lo = p; a.ph_hi = p + 1;
#ifdef PROBE_REP_PHASE
        if (p >= PH_L0 && (p - PH_L0) % PH_PER_LAYER == PROBE_REP_PHASE) {
#ifdef PROBE_VAR
            a.var = PROBE_VAR;
#endif
            hipLaunchKernelGGL(fwd, dim3(grid), dim3(512), LDS_BYTES, stream, a); a.var = 0; }
#endif
        hipLaunchKernelGGL(fwd, dim3(grid), dim3(512), LDS_BYTES, stream, a);
#ifdef PROBE_REP_PHASE_UNUSED
#endif
    }
#endif
    const hipError_t le = hipPeekAtLastError();
    if (le != hipSuccess) fprintf(stderr, "kernel_launch: launch failed: %s\n", hipGetErrorName(le));
}
```
